# Optimizing an MI355X kernel written in HIP

```python
import jax
import jax.numpy as jnp
from jax import lax
import numpy as np

D_MODEL = 4096
BATCH = 1
SEQ = 8192
DEPTH = 2

N_META = 16
N_EVEN = (DEPTH + 1) // 2
N_ODD = DEPTH // 2
A_HEADS = 16
A_KDIM = 128
A_VDIM = D_MODEL // 2 // A_HEADS
A_FDIM = A_HEADS * A_KDIM
A_WIDTH = A_HEADS * A_VDIM
HGRN_CHUNK = 64
HGRN_SUB = 16
B_HDIM = 64
B_QHEADS = D_MODEL // 2 // B_HDIM
B_KVHEADS = B_QHEADS // 8
B_GROUP = B_QHEADS // B_KVHEADS
B_WIDTH = B_QHEADS * B_HDIM
B_KVWIDTH = B_KVHEADS * B_HDIM
WINDOW = 128
ATTN_BLOCK = 128
EVEN_SPLITS = (A_FDIM, A_FDIM, A_WIDTH, A_WIDTH, B_WIDTH, B_KVWIDTH, B_KVWIDTH)
EVEN_IN = sum(EVEN_SPLITS)
EVEN_MIX = A_WIDTH + B_WIDTH
LRU_WIDTH = D_MODEL
LRU_BLOCKS = 16
LRU_BDIM = LRU_WIDTH // LRU_BLOCKS
LRU_CONV = 4
LRU_C = 8.0
D_FF = 256 * ((8 * D_MODEL // 3 + 255) // 256)
FFN_CONV = 3
NORM_EPS = 1e-6
NEG_INF = -1e30

kernel_name = 'hybrid_hgrn2_swa_rglru_block'


def rmsnorm(x, w):
    xf = x.astype(jnp.float32)
    y = xf * lax.rsqrt(jnp.mean(xf * xf, axis=-1, keepdims=True) + NORM_EPS)
    return (y * w.astype(jnp.float32)).astype(x.dtype)


def causal_dwconv(x, w, b):
    width = w.shape[0]
    seq_len = x.shape[1]
    xp = jnp.pad(x, ((0, 0), (width - 1, 0), (0, 0)))
    out = b
    for tap in range(width):
        out = out + xp[:, tap:tap + seq_len] * w[tap]
    return out


def _split(h, sizes):
    idx = np.cumsum(sizes)[:-1].tolist()
    return jnp.split(h, idx, axis=-1)


def hgrn2_heads(q_raw, f_raw, i_raw, g_raw, lb, gn_w):
    bsz, seq_len, _ = q_raw.shape
    f32 = jnp.float32
    pad = HGRN_CHUNK - N_META
    n_sub = HGRN_CHUNK // HGRN_SUB
    q = jax.nn.silu(q_raw.astype(f32))
    forget = lb + (1.0 - lb) * jax.nn.sigmoid(f_raw.astype(f32))
    k = 1.0 - forget
    g = jnp.log(forget)
    v = i_raw.astype(f32)

    def to_chunks(t, dh):
        t = jnp.pad(t, ((0, 0), (pad, 0), (0, 0)))
        n_c = t.shape[1] // HGRN_CHUNK
        return t.reshape(bsz, n_c, HGRN_CHUNK, A_HEADS, dh).transpose(0, 3, 1, 2, 4)

    q = to_chunks(q, A_KDIM)
    k = to_chunks(k, A_KDIM)
    g = to_chunks(g, A_KDIM)
    v = to_chunks(v, A_VDIM)
    b = jnp.cumsum(g, axis=-2)
    b_last = b[..., -1:, :]
    u = jnp.einsum('bhnck,bhncv->bhnkv', k * jnp.exp(b_last - b), v)
    decay = jnp.exp(b_last[..., 0, :])

    def chunk_step(state, inp):
        d, uc = inp
        return d[..., None] * state + uc, state

    s0 = jnp.zeros((bsz, A_HEADS, A_KDIM, A_VDIM), f32)
    _, s_start = lax.scan(chunk_step, s0, (jnp.moveaxis(decay, 2, 0), jnp.moveaxis(u, 2, 0)))
    s_start = jnp.moveaxis(s_start, 0, 2)
    o_inter = jnp.einsum('bhnck,bhnkv->bhncv', q * jnp.exp(b), s_start)

    sub_shape = b.shape[:3] + (n_sub, HGRN_SUB, A_KDIM)
    b_sub = b.reshape(sub_shape)
    ref = jnp.concatenate([jnp.zeros_like(b_sub[..., :1, 0, :]), b_sub[..., :-1, -1, :]], axis=-2)
    q_sc = q.reshape(sub_shape) * jnp.exp(b_sub - ref[..., None, :])
    pos = jnp.arange(HGRN_CHUNK)
    key_ok = pos[None, :] < (jnp.arange(n_sub)[:, None] + 1) * HGRN_SUB
    expo = jnp.where(key_ok[:, :, None], ref[..., :, None, :] - b[..., None, :, :], 0.0)
    k_sc = k[..., None, :, :] * jnp.exp(expo)
    att = jnp.einsum('bhnitk,bhnisk->bhnits', q_sc, k_sc)
    causal = pos.reshape(n_sub, HGRN_SUB)[:, :, None] >= pos[None, None, :]
    att = jnp.where(causal, att, 0.0)
    o_intra = jnp.einsum('bhnits,bhnsv->bhnitv', att, v).reshape(o_inter.shape)
    o = jnp.moveaxis(o_inter + o_intra, 1, 3)
    o = o.reshape(bsz, -1, A_HEADS, A_VDIM)[:, pad:]
    gate = jax.nn.silu(g_raw.astype(f32)).reshape(bsz, seq_len, A_HEADS, A_VDIM)
    o = rmsnorm(o, gn_w) * gate
    return o.reshape(bsz, seq_len, A_WIDTH).astype(q_raw.dtype)


def swa_sink_heads(q_raw, k_raw, v_raw, sinks):
    bsz, seq_len, _ = q_raw.shape
    f32 = jnp.float32
    pad = ATTN_BLOCK - N_META
    padw = ((0, 0), (pad, 0), (0, 0))
    qp = jnp.pad(q_raw, padw)
    kp = jnp.pad(k_raw, padw)
    vp = jnp.pad(v_raw, padw)
    n_b = qp.shape[1] // ATTN_BLOCK
    q = qp.reshape(bsz, n_b, ATTN_BLOCK, B_KVHEADS, B_GROUP, B_HDIM)
    k = kp.reshape(bsz, n_b, ATTN_BLOCK, B_KVHEADS, B_HDIM)
    v = vp.reshape(bsz, n_b, ATTN_BLOCK, B_KVHEADS, B_HDIM)

    def band(t):
        prev = jnp.pad(t, ((0, 0), (1, 0), (0, 0), (0, 0), (0, 0)))[:, :-1]
        return jnp.concatenate([prev, t], axis=2)

    k_band = band(k)
    v_band = band(v)
    k_meta = k_raw[:, :N_META].reshape(bsz, N_META, B_KVHEADS, B_HDIM)
    v_meta = v_raw[:, :N_META].reshape(bsz, N_META, B_KVHEADS, B_HDIM)
    scale = B_HDIM ** -0.5
    s_meta = jnp.einsum('bnqhgd,bmhd->bnhgqm', q, k_meta, preferred_element_type=f32) * scale
    s_band = jnp.einsum('bnqhgd,bnkhd->bnhgqk', q, k_band, preferred_element_type=f32) * scale
    qpos = jnp.arange(n_b)[:, None] * ATTN_BLOCK + jnp.arange(ATTN_BLOCK)[None, :]
    kpos = (jnp.arange(n_b)[:, None] - 1) * ATTN_BLOCK + jnp.arange(2 * ATTN_BLOCK)[None, :]
    qp3 = qpos[:, :, None]
    kp3 = kpos[:, None, :]
    band_ok = (kp3 <= qp3) & (qp3 - kp3 < WINDOW) & (kp3 >= ATTN_BLOCK)
    meta_ok = (qp3 >= ATTN_BLOCK) | (qp3 - pad >= jnp.arange(N_META)[None, None, :])
    sink = jnp.broadcast_to(sinks.astype(f32).reshape(1, 1, B_KVHEADS, B_GROUP, 1, 1), s_band.shape[:-1] + (1,))
    logits = jnp.concatenate([
        jnp.where(meta_ok[None, :, None, None], s_meta, NEG_INF),
        jnp.where(band_ok[None, :, None, None], s_band, NEG_INF),
        sink], axis=-1)
    p = jax.nn.softmax(logits, axis=-1).astype(v_raw.dtype)
    out = (jnp.einsum('bnhgqm,bmhd->bnqhgd', p[..., :N_META], v_meta)
           + jnp.einsum('bnhgqk,bnkhd->bnqhgd', p[..., N_META:N_META + 2 * ATTN_BLOCK], v_band))
    return out.reshape(bsz, n_b * ATTN_BLOCK, B_WIDTH)[:, pad:]


def even_mixer(xn, w_in, lb, gn_w, sinks, w_out):
    h = xn @ w_in
    q_a, f_a, i_a, g_a, q_b, k_b, v_b = _split(h, EVEN_SPLITS)
    o_a = hgrn2_heads(q_a, f_a, i_a, g_a, lb, gn_w)
    o_b = swa_sink_heads(q_b, k_b, v_b, sinks)
    return jnp.concatenate([o_a, o_b], axis=-1) @ w_out


def rglru(x, w_a, b_a, w_x, b_x, a_param):
    bsz, seq_len, _ = x.shape
    f32 = jnp.float32
    xf = x.astype(f32)
    xb = xf.reshape(bsz, seq_len, LRU_BLOCKS, LRU_BDIM)
    gate_r = jax.nn.sigmoid(jnp.einsum('blhi,hij->blhj', xb, w_a.astype(f32)).reshape(bsz, seq_len, LRU_WIDTH) + b_a.astype(f32))
    gate_i = jax.nn.sigmoid(jnp.einsum('blhi,hij->blhj', xb, w_x.astype(f32)).reshape(bsz, seq_len, LRU_WIDTH) + b_x.astype(f32))
    log_a = LRU_C * gate_r * jax.nn.log_sigmoid(a_param.astype(f32))
    a = jnp.exp(log_a)
    inp = jnp.sqrt(-jnp.expm1(2.0 * log_a)) * (gate_i * xf)

    def combine(left, right):
        a_l, b_l = left
        a_r, b_r = right
        return a_l * a_r, a_r * b_l + b_r

    _, h = lax.associative_scan(combine, (a, inp), axis=1)
    return h.astype(x.dtype)


def odd_mixer(xn, w_in, conv_w, conv_b, w_a, b_a, w_x, b_x, a_param, w_out):
    y_br, x_br = jnp.split(xn @ w_in, 2, axis=-1)
    y_br = jax.nn.gelu(y_br, approximate=True)
    x_br = causal_dwconv(x_br, conv_w, conv_b)
    return (rglru(x_br, w_a, b_a, w_x, b_x, a_param) * y_br) @ w_out


def conv_ffn(xn, w_gu, conv_w, conv_b, w_down):
    gate, up = jnp.split(xn @ w_gu, 2, axis=-1)
    gate = causal_dwconv(gate, conv_w, conv_b)
    return (jax.nn.gelu(gate, approximate=True) * up) @ w_down


def setup_inputs(seed: int = 0) -> dict:
    key = jax.random.key(seed)
    ks = jax.random.split(key, 24)
    f32 = jnp.float32
    nrm = jax.random.normal

    def dense(k, shape, fan_in):
        return nrm(k, shape, f32) * fan_in ** -0.5

    x = nrm(ks[0], (BATCH, SEQ, D_MODEL), f32)
    meta_tokens = nrm(ks[1], (N_META, D_MODEL), f32)
    norm_w = 1.0 + 0.02 * nrm(ks[2], (DEPTH, 4, D_MODEL), f32)
    w_in_even = dense(ks[3], (N_EVEN, D_MODEL, EVEN_IN), D_MODEL)
    lb_logits = 0.1 * nrm(ks[4], (N_EVEN + 1, A_FDIM), f32)
    hgrn_gn_w = 1.0 + 0.02 * nrm(ks[5], (N_EVEN, A_VDIM), f32)
    attn_sinks = nrm(ks[6], (N_EVEN, B_QHEADS), f32)
    w_out_even = dense(ks[7], (N_EVEN, EVEN_MIX, D_MODEL), EVEN_MIX)
    w_in_odd = dense(ks[8], (N_ODD, D_MODEL, 2 * LRU_WIDTH), D_MODEL)
    lru_conv_w = dense(ks[9], (N_ODD, LRU_CONV, LRU_WIDTH), LRU_CONV)
    lru_conv_b = 0.01 * nrm(ks[10], (N_ODD, LRU_WIDTH), f32)
    lru_wa = dense(ks[11], (N_ODD, LRU_BLOCKS, LRU_BDIM, LRU_BDIM), LRU_BDIM)
    lru_ba = 0.01 * nrm(ks[12], (N_ODD, LRU_WIDTH), f32)
    lru_wx = dense(ks[13], (N_ODD, LRU_BLOCKS, LRU_BDIM, LRU_BDIM), LRU_BDIM)
    lru_bx = 0.01 * nrm(ks[14], (N_ODD, LRU_WIDTH), f32)
    a0 = jax.random.uniform(ks[15], (N_ODD, LRU_WIDTH), f32, 0.9, 0.999) ** (1.0 / LRU_C)
    lru_a_param = jnp.log(a0) - jnp.log1p(-a0)
    w_out_odd = dense(ks[16], (N_ODD, LRU_WIDTH, D_MODEL), LRU_WIDTH)
    ffn_w_gu = dense(ks[17], (DEPTH, D_MODEL, 2 * D_FF), D_MODEL)
    ffn_conv_w = dense(ks[18], (DEPTH, FFN_CONV, D_FF), FFN_CONV)
    ffn_conv_b = 0.01 * nrm(ks[19], (DEPTH, D_FF), f32)
    ffn_w_down = dense(ks[20], (DEPTH, D_FF, D_MODEL), D_FF)
    return {
        'x': x, 'meta_tokens': meta_tokens, 'norm_w': norm_w,
        'w_in_even': w_in_even, 'lb_logits': lb_logits, 'hgrn_gn_w': hgrn_gn_w,
        'attn_sinks': attn_sinks, 'w_out_even': w_out_even,
        'w_in_odd': w_in_odd, 'lru_conv_w': lru_conv_w, 'lru_conv_b': lru_conv_b,
        'lru_wa': lru_wa, 'lru_ba': lru_ba, 'lru_wx': lru_wx, 'lru_bx': lru_bx,
        'lru_a_param': lru_a_param, 'w_out_odd': w_out_odd,
        'ffn_w_gu': ffn_w_gu, 'ffn_conv_w': ffn_conv_w, 'ffn_conv_b': ffn_conv_b,
        'ffn_w_down': ffn_w_down,
    }


def reference(x, meta_tokens, norm_w, w_in_even, lb_logits, hgrn_gn_w, attn_sinks, w_out_even,
              w_in_odd, lru_conv_w, lru_conv_b, lru_wa, lru_ba, lru_wx, lru_bx, lru_a_param, w_out_odd,
              ffn_w_gu, ffn_conv_w, ffn_conv_b, ffn_w_down):
    bsz = x.shape[0]
    meta = jnp.broadcast_to(meta_tokens.astype(x.dtype)[None], (bsz, N_META, D_MODEL))
    h = jnp.concatenate([meta, x], axis=1)
    lower_bounds = jnp.cumsum(jax.nn.softmax(lb_logits.astype(jnp.float32), axis=0), axis=0)
    for layer in range(DEPTH):
        j = layer // 2
        xn = rmsnorm(h, norm_w[layer, 0])
        if layer % 2 == 0:
            mix = even_mixer(xn, w_in_even[j], lower_bounds[j], hgrn_gn_w[j], attn_sinks[j], w_out_even[j])
        else:
            mix = odd_mixer(xn, w_in_odd[j], lru_conv_w[j], lru_conv_b[j], lru_wa[j], lru_ba[j],
                            lru_wx[j], lru_bx[j], lru_a_param[j], w_out_odd[j])
        h = h + rmsnorm(mix, norm_w[layer, 1])
        ff = conv_ffn(rmsnorm(h, norm_w[layer, 2]), ffn_w_gu[layer], ffn_conv_w[layer],
                      ffn_conv_b[layer], ffn_w_down[layer])
        h = h + rmsnorm(ff, norm_w[layer, 3])
    return h[:, N_META:]
```

```cpp
#include <hip/hip_runtime.h>
#include <cstdio>
#include <cstdint>

#define GAS __attribute__((address_space(1)))
#define LAS __attribute__((address_space(3)))
typedef unsigned short bf16;
typedef unsigned v4u __attribute__((ext_vector_type(4)));
typedef unsigned v2u __attribute__((ext_vector_type(2)));
typedef float f32x4 __attribute__((ext_vector_type(4)));
typedef float f32x2 __attribute__((ext_vector_type(2)));
typedef short bf16x8 __attribute__((ext_vector_type(8)));
typedef short bf16x4 __attribute__((ext_vector_type(4)));
typedef GAS unsigned gu32;

constexpr int DM = 4096, SEQ = 8192, NMETA = 16, LTOK = SEQ + NMETA;
constexpr int MP = 8448;
constexpr int NPAN = MP / 256;
constexpr int A_HEADS = 16, A_K = 128, A_V = 128, A_F = 2048;
constexpr int B_HD = 64, B_QH = 32, B_KVH = 4, B_GRP = 8, B_W = 2048, B_KVW = 256;
constexpr int EVEN_IN = 10752, DFF = 11008, LRU_W = 4096;
constexpr int NCHUNK = 129;
constexpr float NORM_EPS = 1e-6f;

constexpr size_t MiB = 1u << 20;
constexpr size_t WS_CTL = 0, CTL_ZERO_BYTES = 1 * MiB;
constexpr size_t SZ_WIN_E = (size_t)EVEN_IN * DM * 2, SZ_W44 = (size_t)DM * DM * 2, SZ_WIN_O = (size_t)8192 * DM * 2, SZ_WG = (size_t)8192 * 256 * 2,
                 SZ_WGU = (size_t)2 * DFF * DM * 2, SZ_WD = (size_t)DM * DFF * 2;
constexpr size_t WS_WIN_E = 1 * MiB;
constexpr size_t WS_WOUT_E = WS_WIN_E + SZ_WIN_E;
constexpr size_t WS_WIN_O = WS_WOUT_E + SZ_W44;
constexpr size_t WS_WG = WS_WIN_O + SZ_WIN_O;
constexpr size_t WS_WOUT_O = WS_WG + SZ_WG;
constexpr size_t WS_WGU = WS_WOUT_O + SZ_W44;
constexpr size_t WS_WD = WS_WGU + 2 * SZ_WGU;
constexpr size_t WS_H = WS_WD + 2 * SZ_WD;
constexpr size_t SZ_F32ROW = (size_t)MP * DM * 4, SZ_BFROW = (size_t)MP * DM * 2;
constexpr size_t WS_XN = WS_H + SZ_F32ROW;
constexpr size_t WS_Y = WS_XN + SZ_BFROW;
constexpr size_t WS_AR = WS_Y + SZ_F32ROW;
constexpr size_t AR_QA = 0;
constexpr size_t AR_GL = AR_QA + (size_t)MP * 2048 * 4;
constexpr size_t AR_GT = AR_GL + (size_t)MP * 2048 * 4;
constexpr size_t AR_VA = AR_GT + (size_t)MP * 2048 * 4;
constexpr size_t AR_QB = AR_VA + (size_t)MP * 2048 * 2;
constexpr size_t AR_KB = AR_QB + (size_t)MP * 2048 * 2;
constexpr size_t AR_VB = AR_KB + (size_t)MP * 256 * 2;
constexpr size_t AR_US = AR_VB + (size_t)MP * 256 * 2;
constexpr size_t AR_DS = AR_US + (size_t)A_HEADS * NCHUNK * 16384 * 4;
constexpr size_t AR_MIX = AR_DS + (size_t)A_HEADS * NCHUNK * 128 * 4;
constexpr size_t AR_L0_END = AR_MIX + SZ_BFROW;
constexpr size_t AR_G = 0;
constexpr size_t AR_U = AR_G + (size_t)MP * DFF * 4;
constexpr size_t AR_ACT = AR_U + (size_t)MP * DFF * 2;
constexpr size_t AR_FFN_END = AR_ACT + (size_t)MP * DFF * 2;
constexpr size_t AR_YBR = 0;
constexpr size_t AR_XBR = AR_YBR + SZ_BFROW;
constexpr size_t AR_XC = AR_XBR + SZ_F32ROW;
constexpr size_t AR_XCB = AR_XC + SZ_F32ROW;
constexpr size_t AR_A = AR_XCB + SZ_BFROW;
constexpr size_t AR_BI = AR_A + SZ_F32ROW;
constexpr size_t AR_CA = AR_BI + SZ_F32ROW;
constexpr size_t AR_CB = AR_CA + (size_t)NCHUNK * DM * 4;
constexpr size_t AR_LO = AR_CB + (size_t)NCHUNK * DM * 4;
constexpr size_t AR_L1_END = AR_LO + SZ_BFROW;
constexpr size_t AR_SIZE = (AR_FFN_END > AR_L0_END ? (AR_FFN_END > AR_L1_END ? AR_FFN_END : AR_L1_END) : (AR_L0_END > AR_L1_END ? AR_L0_END : AR_L1_END));
constexpr size_t WS_END = WS_AR + AR_SIZE;

constexpr size_t WS_LS8 = 512 * 1024;
constexpr int CW_TMO = 0, CW_CODE = 1;
constexpr int CW_BAR = 4096;

constexpr int RING_OFF = 0, RING_BYTES = 131072;
constexpr int LDSCTL_OFF = RING_BYTES, MISC_OFF = LDSCTL_OFF + 320;
constexpr int LDS_BYTES = 147456;
constexpr int NWAVES = 8;

#define RLX_AGENT __ATOMIC_RELAXED, __HIP_MEMORY_SCOPE_AGENT
#define LDS_WAIT() asm volatile("s_waitcnt lgkmcnt(0)" ::: "memory")
#define VM_WAIT() asm volatile("s_waitcnt vmcnt(0)" ::: "memory")
__device__ __forceinline__ unsigned f2bf(float f) { unsigned u = __builtin_bit_cast(unsigned, f); return (u + 0x7fffu + ((u >> 16) & 1u)) >> 16; }
__device__ __forceinline__ unsigned pk2(float lo, float hi) { return f2bf(lo) | (f2bf(hi) << 16); }
__device__ __forceinline__ float bflo(unsigned w) { return __builtin_bit_cast(float, w << 16); }
__device__ __forceinline__ float bfhi(unsigned w) { return __builtin_bit_cast(float, w & 0xffff0000u); }
__device__ __forceinline__ float bf1(bf16 h) { return __builtin_bit_cast(float, ((unsigned)h) << 16); }
__device__ __forceinline__ float fexp(float x) { return __builtin_amdgcn_exp2f(x * 1.4426950408889634f); }
__device__ __forceinline__ float frcp(float x) { return __builtin_amdgcn_rcpf(x); }
__device__ __forceinline__ float fsigmoid(float x) { return frcp(1.0f + fexp(-x)); }
__device__ __forceinline__ float fsilu(float x) { return x * fsigmoid(x); }
__device__ __forceinline__ float fgelu_tanh(float x) { const float t = 0.7978845608028654f * (x + 0.044715f * x * x * x); return x * frcp(1.0f + fexp(-2.0f * t)); }
__device__ __forceinline__ float wave_sum(float v) {
#pragma unroll
    for (int o = 1; o < 64; o <<= 1) v += __shfl_xor(v, o);
    return v;
}
namespace pg8 {
#define PG8_LAS __attribute__((address_space(3)))
typedef unsigned short bf16_t;
typedef short bf16x8 __attribute__((ext_vector_type(8)));
typedef float f32x4 __attribute__((ext_vector_type(4)));
typedef unsigned u32x4 __attribute__((ext_vector_type(4)));
constexpr int BM = 256, BK = 64, HALF = 128, HTB = HALF * BK * 2  , STAGE_BYTES = 8 * HTB, NXCD = 8, WGM = 8;

__host__ __device__ __forceinline__ int lds_byte(int r, int c) { const int st = (r >> 4) * 2 + (c >> 5), rr = r & 15, cc = c & 31, ob = rr * 64 + cc * 2; return st * 1024 + (ob ^ (((ob >> 9) & 1) << 5)); }
__host__ __device__ __forceinline__ void stage_rc(int b, int& R, int& C) { const int st = b / 1024, sb = b % 1024, swz = sb ^ (((sb >> 9) & 1) << 5); R = (st >> 1) * 16 + swz / 64; C = (st & 1) * 32 + (swz % 64) / 2; }
__host__ __device__ __forceinline__ int perm32(int rho) { const int n = rho >> 4, i = rho & 15; return 8 * (i >> 2) + 4 * n + (i & 3); }

struct Unit { int pm, pn; };
struct Gemm { const bf16_t* A; const bf16_t* Bt; int M, N, K; int lda, ldb; int acol_shift; };

struct StaticOrder {
    int nM, nN, nwg, G, c;
    __host__ __device__ void init(int M, int N, int G_, int c_) { nM = M / BM; nN = N / BM; nwg = nM * nN; G = G_; c = c_; }
    __host__ __device__ bool next(int i, Unit& u) const {
        const long L = (long)i * G + c; if (L >= nwg) return false;
        int wgid = (int)L; { const int q = nwg / NXCD, r = nwg % NXCD, xcd = wgid % NXCD, off = wgid / NXCD; wgid = (xcd < r ? xcd * (q + 1) : r * (q + 1) + (xcd - r) * q) + off; }
        const int nig = WGM * nN, gid = wgid / nig, fm = gid * WGM, gsz = (nM - fm) < WGM ? (nM - fm) : WGM;
        u.pm = fm + ((wgid % nig) % gsz); u.pn = (wgid % nig) / gsz; return true;
    }
    __device__ __forceinline__ void a_ready(const Unit&) const {}
    __device__ __forceinline__ void done(const Unit&) const {}
};
__device__ __forceinline__ unsigned cvt_pk_bf16(float lo, float hi) { unsigned r; asm volatile("v_cvt_pk_bf16_f32 %0, %1, %2" : "=v"(r) : "v"(lo), "v"(hi)); return r; }
}
namespace pg8 {
__device__ __forceinline__ void st_f32x8(float* p, f32x4 a, f32x4 b) { *(f32x4*)p = a; *(f32x4*)(p + 4) = b; }
__device__ __forceinline__ void st_bf16x8(bf16_t* p, f32x4 a, f32x4 b) { u32x4 w; w.x = cvt_pk_bf16(a[0], a[1]); w.y = cvt_pk_bf16(a[2], a[3]); w.z = cvt_pk_bf16(b[0], b[1]); w.w = cvt_pk_bf16(b[2], b[3]); *(u32x4*)p = w; }

struct EpiF32 {
    static constexpr bool PERM = true, AFTER_DRAIN = false;
    float* C; int ldc;
    __device__ __forceinline__ void operator()(const f32x4 (&acc)[2][2][4][2], const Unit& u, int wr, int wc, int fr, int fq) const {
        const unsigned lo = (unsigned)((wr * 64 + fr) * ldc + wc * 32 + 8 * fq);
#pragma unroll
        for (int ai = 0; ai < 2; ++ai)
#pragma unroll
            for (int m = 0; m < 4; ++m) { float* rowp = C + (size_t)(u.pm * BM + ai * HALF + m * 16) * ldc + u.pn * BM;
#pragma unroll
                for (int bj = 0; bj < 2; ++bj) st_f32x8(rowp + lo + bj * HALF, acc[ai][bj][m][0], acc[ai][bj][m][1]); }
    }
};

struct EpiInEven {
    static constexpr bool PERM = true, AFTER_DRAIN = false;
    float* QA; float* GL; float* GT; bf16_t* VA; bf16_t* QB; bf16_t* KB; bf16_t* VB; const float* lbl;
    __device__ __forceinline__ void operator()(const f32x4 (&acc)[2][2][4][2], const Unit& u, int wr, int wc, int fr, int fq) const {
        const int seg = u.pn >> 3; const int cu = (u.pn & 7) * BM;
        const unsigned lc = (unsigned)(wc * 32 + 8 * fq);
        const unsigned lo = (unsigned)((wr * 64 + fr) * 2048) + lc;
        if (seg == 0 || seg == 3) {
            float* D = (seg == 0 ? QA : GT) + (size_t)(u.pm * BM) * 2048 + cu;
#pragma unroll
            for (int ai = 0; ai < 2; ++ai)
#pragma unroll
                for (int m = 0; m < 4; ++m) { float* rowp = D + (size_t)(ai * HALF + m * 16) * 2048;
#pragma unroll
                    for (int bj = 0; bj < 2; ++bj) { f32x4 a = acc[ai][bj][m][0], b = acc[ai][bj][m][1];
#pragma unroll
                        for (int j = 0; j < 4; ++j) { a[j] = fsilu(a[j]); b[j] = fsilu(b[j]); }
                        st_f32x8(rowp + lo + bj * HALF, a, b); } }
        } else if (seg == 1) {
            f32x4 lb[2][2];
#pragma unroll
            for (int bj = 0; bj < 2; ++bj)
#pragma unroll
                for (int n = 0; n < 2; ++n) { const f32x4 l0 = *(const f32x4*)(lbl + cu + lc + bj * HALF + 4 * n), l1 = *(const f32x4*)(lbl + 2048 + cu + lc + bj * HALF + 4 * n);
#pragma unroll
                    for (int j = 0; j < 4; ++j) lb[bj][n][j] = frcp(1.0f + fexp(l1[j] - l0[j])); }
            float* D = GL + (size_t)(u.pm * BM) * 2048 + cu;
#pragma unroll
            for (int ai = 0; ai < 2; ++ai)
#pragma unroll
                for (int m = 0; m < 4; ++m) { float* rowp = D + (size_t)(ai * HALF + m * 16) * 2048;
#pragma unroll
                    for (int bj = 0; bj < 2; ++bj) { f32x4 a = acc[ai][bj][m][0], b = acc[ai][bj][m][1];
#pragma unroll
                        for (int j = 0; j < 4; ++j) { a[j] = __logf(lb[bj][0][j] + (1.0f - lb[bj][0][j]) * fsigmoid(a[j])); b[j] = __logf(lb[bj][1][j] + (1.0f - lb[bj][1][j]) * fsigmoid(b[j])); }
                        st_f32x8(rowp + lo + bj * HALF, a, b); } }
        } else if (seg == 2 || seg == 4) {
            bf16_t* D = (seg == 2 ? VA : QB) + (size_t)(u.pm * BM) * 2048 + cu;
#pragma unroll
            for (int ai = 0; ai < 2; ++ai)
#pragma unroll
                for (int m = 0; m < 4; ++m) { bf16_t* rowp = D + (size_t)(ai * HALF + m * 16) * 2048;
#pragma unroll
                    for (int bj = 0; bj < 2; ++bj) st_bf16x8(rowp + lo + bj * HALF, acc[ai][bj][m][0], acc[ai][bj][m][1]); }
        } else {
            bf16_t* D = ((u.pn == 40) ? KB : VB) + (size_t)(u.pm * BM) * 256; const unsigned lo2 = (unsigned)((wr * 64 + fr) * 256) + lc;
#pragma unroll
            for (int ai = 0; ai < 2; ++ai)
#pragma unroll
                for (int m = 0; m < 4; ++m) { bf16_t* rowp = D + (size_t)(ai * HALF + m * 16) * 256;
#pragma unroll
                    for (int bj = 0; bj < 2; ++bj) st_bf16x8(rowp + lo2 + bj * HALF, acc[ai][bj][m][0], acc[ai][bj][m][1]); }
        }
    }
};

struct EpiGU {
    static constexpr bool PERM = true, AFTER_DRAIN = false;
    float* G; bf16_t* U;
    __device__ __forceinline__ void operator()(const f32x4 (&acc)[2][2][4][2], const Unit& u, int wr, int wc, int fr, int fq) const {
        const unsigned lo = (unsigned)((wr * 64 + fr) * DFF + wc * 32 + 8 * fq);
#pragma unroll
        for (int ai = 0; ai < 2; ++ai)
#pragma unroll
            for (int m = 0; m < 4; ++m) { const size_t ro = (size_t)(u.pm * BM + ai * HALF + m * 16) * DFF + u.pn * HALF;
                st_f32x8(G + ro + lo, acc[ai][0][m][0], acc[ai][0][m][1]); st_bf16x8(U + ro + lo, acc[ai][1][m][0], acc[ai][1][m][1]); }
    }
};

struct EpiInOdd {
    static constexpr bool PERM = true, AFTER_DRAIN = false;
    bf16_t* Y; float* X;
    __device__ __forceinline__ void operator()(const f32x4 (&acc)[2][2][4][2], const Unit& u, int wr, int wc, int fr, int fq) const {
        const unsigned lo = (unsigned)((wr * 64 + fr) * DM + wc * 32 + 8 * fq);
        if (u.pn < 16) {
#pragma unroll
            for (int ai = 0; ai < 2; ++ai)
#pragma unroll
                for (int m = 0; m < 4; ++m) { bf16_t* rowp = Y + (size_t)(u.pm * BM + ai * HALF + m * 16) * DM + (u.pn & 15) * BM;
#pragma unroll
                    for (int bj = 0; bj < 2; ++bj) { f32x4 a = acc[ai][bj][m][0], b = acc[ai][bj][m][1];
#pragma unroll
                        for (int j = 0; j < 4; ++j) { a[j] = fgelu_tanh(a[j]); b[j] = fgelu_tanh(b[j]); }
                        st_bf16x8(rowp + lo + bj * HALF, a, b); } }
        } else {
#pragma unroll
            for (int ai = 0; ai < 2; ++ai)
#pragma unroll
                for (int m = 0; m < 4; ++m) { float* rowp = X + (size_t)(u.pm * BM + ai * HALF + m * 16) * DM + (u.pn & 15) * BM;
#pragma unroll
                    for (int bj = 0; bj < 2; ++bj) st_f32x8(rowp + lo + bj * HALF, acc[ai][bj][m][0], acc[ai][bj][m][1]); }
        }
    }
};

struct EpiGates {
    static constexpr bool PERM = true, AFTER_DRAIN = false;
    const float* XC; const float* ba; const float* bx; const float* ls8; float* A; float* BI;
    __device__ __forceinline__ void operator()(const f32x4 (&acc)[2][2][4][2], const Unit& u, int wr, int wc, int fr, int fq) const {
        const int chu = (u.pn >> 1) * BM + (u.pn & 1) * HALF; const unsigned lc = (unsigned)(wc * 32 + 8 * fq), lo = (unsigned)((wr * 64 + fr) * DM) + lc;
        f32x4 vba[2], vbx[2], vls[2];
#pragma unroll
        for (int n = 0; n < 2; ++n) { vba[n] = *(const f32x4*)(ba + chu + lc + 4 * n); vbx[n] = *(const f32x4*)(bx + chu + lc + 4 * n); vls[n] = *(const f32x4*)(ls8 + chu + lc + 4 * n); }
#pragma unroll
        for (int ai = 0; ai < 2; ++ai)
#pragma unroll
            for (int m = 0; m < 4; ++m) { const size_t ro = (size_t)(u.pm * BM + ai * HALF + m * 16) * DM + chu;
#pragma unroll
                for (int n = 0; n < 2; ++n) {
                    const f32x4 x = *(const f32x4*)(XC + ro + lo + 4 * n); f32x4 a, b;
#pragma unroll
                    for (int j = 0; j < 4; ++j) { const float la = vls[n][j] * fsigmoid(acc[ai][0][m][n][j] + vba[n][j]); const float t = 2.0f * la;
                        const float ser = t * (1.0f + 0.5f * t * (1.0f + (1.0f / 3.0f) * t * (1.0f + 0.25f * t * (1.0f + 0.2f * t * (1.0f + (1.0f / 6.0f) * t)))));
                        const float em1 = t > -0.25f ? ser : fexp(t) - 1.0f;
                        a[j] = fexp(la); b[j] = __builtin_sqrtf(-em1) * (fsigmoid(acc[ai][1][m][n][j] + vbx[n][j]) * x[j]); }
                    *(f32x4*)(A + ro + lo + 4 * n) = a; *(f32x4*)(BI + ro + lo + 4 * n) = b; }
                asm volatile("" ::: "memory"); }
    }
};
}
namespace pg8 {
template <class Epi, class Sched, bool ALIGN_EPI = false, bool SP2 = false>
__device__ __forceinline__ void gemm_phase(PG8_LAS unsigned char* lds, const Gemm g, const Sched& S, const Epi& E) {
    const int tid = threadIdx.x, wid = __builtin_amdgcn_readfirstlane(tid >> 6), lane = tid & 63, wr = wid >> 2, wc = wid & 3, fr = lane & 15, fq = lane >> 4;
    const int K = g.K, nt = K / BK;
    unsigned voffA[2], voffB[2];
#pragma unroll
    for (int i = 0; i < 2; ++i) { int R, C; stage_rc(tid * 16 + i * 8192, R, C); const int Rb = Epi::PERM ? ((R & ~31) + perm32(R & 31)) : R;
        voffA[i] = (unsigned)(R * g.lda + C) * 2u; voffB[i] = (unsigned)(Rb * g.ldb + C) * 2u; }
    const size_t kstep = (size_t)(BK * 2);
    const size_t hstepA = (size_t)HALF * g.lda * 2, hstepB = (size_t)HALF * g.ldb * 2;
    const size_t tstepA = 2 * hstepA, tstepB = 2 * hstepB;
#define PG8_ABASE(u) ((const char*)g.A + (size_t)(u).pm * tstepA + (g.acol_shift >= 0 ? (size_t)(((u).pn >> g.acol_shift) * 512) : (size_t)0))
    const unsigned ldsw = (unsigned)wid * 1024u;
    const int aoff = lds_byte(wr * 64 + fr, fq * 8), boff = lds_byte(wc * 32 + fr, fq * 8);
#define PG8_SA(b, h) (((b) * 2 + (h)) * HTB)
#define PG8_SB(b, h) ((4 + (b) * 2 + (h)) * HTB)
#define PG8_STAGE(bufoff, gbase, voff) do { _Pragma("unroll") for (int _i = 0; _i < 2; ++_i) \
        __builtin_amdgcn_global_load_lds((const unsigned*)((const char*)(gbase) + (voff)[_i]), (PG8_LAS unsigned*)(lds + (bufoff) + ldsw + _i * 8192), 16, 0, 0); } while (0)
#define PG8_LDA(dst, b, h) do { _Pragma("unroll") for (int m = 0; m < 4; ++m) _Pragma("unroll") for (int k = 0; k < 2; ++k) dst[m][k] = *(const PG8_LAS bf16x8*)(lds + PG8_SA(b, h) + aoff + m * 2048 + k * 1024); } while (0)
#define PG8_LDB(dst, b, h) do { _Pragma("unroll") for (int n = 0; n < 2; ++n) _Pragma("unroll") for (int k = 0; k < 2; ++k) dst[n][k] = *(const PG8_LAS bf16x8*)(lds + PG8_SB(b, h) + boff + n * 2048 + k * 1024); } while (0)
#define PG8_MMA(ai, bj, At, Bt) do { __builtin_amdgcn_s_setprio(1); _Pragma("unroll") for (int m = 0; m < 4; ++m) _Pragma("unroll") for (int n = 0; n < 2; ++n) _Pragma("unroll") for (int k = 0; k < 2; ++k) \
        acc[ai][bj][m][n] = __builtin_amdgcn_mfma_f32_16x16x32_bf16(Bt[n][k], At[m][k], acc[ai][bj][m][n], 0, 0, 0); __builtin_amdgcn_s_setprio(0); } while (0)
#define PG8_WAIT_V(n) asm volatile("s_waitcnt vmcnt(" #n ")" ::: "memory")
#define PG8_WAIT_L(n) asm volatile("s_waitcnt lgkmcnt(" #n ")" ::: "memory")
#define PG8_BAR __builtin_amdgcn_s_barrier()
#define PG8_SCHED __builtin_amdgcn_sched_barrier(0)
    Unit cur, nxt; int ui = 0;
    if (!S.next(0, cur)) return;
    f32x4 acc[2][2][4][2];
#pragma unroll
    for (int a = 0; a < 2; ++a)
#pragma unroll
        for (int b = 0; b < 2; ++b)
#pragma unroll
            for (int m = 0; m < 4; ++m)
#pragma unroll
                for (int n = 0; n < 2; ++n) acc[a][b][m][n] = (f32x4){0.f, 0.f, 0.f, 0.f};
    bf16x8 At[4][2], B0[2][2], B1[2][2];
    const char* cA = PG8_ABASE(cur); const char* cB = (const char*)g.Bt + (size_t)cur.pn * tstepB;
    S.a_ready(cur);
    if constexpr (SP2) {
        PG8_STAGE(PG8_SB(0, 0), cB, voffB); PG8_STAGE(PG8_SB(0, 1), cB + hstepB, voffB); PG8_STAGE(PG8_SA(0, 0), cA, voffA); PG8_STAGE(PG8_SA(0, 1), cA + hstepA, voffA);
        if (wr == 1) PG8_BAR;
        PG8_WAIT_V(2); PG8_BAR;
        PG8_STAGE(PG8_SB(1, 0), cB + kstep, voffB); PG8_STAGE(PG8_SA(1, 0), cA + kstep, voffA); PG8_STAGE(PG8_SB(1, 1), cB + hstepB + kstep, voffB);
        PG8_WAIT_V(6); PG8_BAR;
    } else {
        PG8_STAGE(PG8_SB(0, 0), cB, voffB); PG8_STAGE(PG8_SA(0, 0), cA, voffA); PG8_STAGE(PG8_SB(0, 1), cB + hstepB, voffB); PG8_STAGE(PG8_SA(0, 1), cA + hstepA, voffA);
        if (wr == 1) PG8_BAR;
        PG8_WAIT_V(4); PG8_BAR;
        PG8_STAGE(PG8_SB(1, 0), cB + kstep, voffB); PG8_STAGE(PG8_SA(1, 0), cA + kstep, voffA); PG8_STAGE(PG8_SB(1, 1), cB + hstepB + kstep, voffB);
        PG8_WAIT_V(6); PG8_BAR;
    }
    for (;;) {
        const bool has_next = S.next(ui + 1, nxt);
        const char* nA = has_next ? PG8_ABASE(nxt) : cA; const char* nB = has_next ? (const char*)g.Bt + (size_t)nxt.pn * tstepB : cB;
#pragma nounroll
        for (int t = 0; t < nt; t += 2) {
            const bool last = (t == nt - 2);
            const char* a1 = cA + (size_t)(t + 1) * kstep;
            const char* a2 = last ? nA : cA + (size_t)(t + 2) * kstep; const char* b2 = last ? nB : cB + (size_t)(t + 2) * kstep;
            const char* a3 = a2 + kstep; const char* b3 = b2 + kstep;
            if (last && has_next) S.a_ready(nxt);
            if constexpr (SP2) {
            PG8_LDB(B0, 0, 0); PG8_LDB(B1, 0, 1); PG8_SCHED; PG8_LDA(At, 0, 0); PG8_STAGE(PG8_SA(1, 1), a1 + hstepA, voffA);
            PG8_WAIT_V(8); PG8_WAIT_L(0); PG8_BAR; PG8_MMA(0, 0, At, B0); PG8_MMA(0, 1, At, B1); PG8_BAR; PG8_SCHED;
            PG8_LDA(At, 0, 1); PG8_STAGE(PG8_SB(0, 0), b2, voffB); PG8_STAGE(PG8_SB(0, 1), b2 + hstepB, voffB); PG8_STAGE(PG8_SA(0, 0), a2, voffA);
            PG8_WAIT_V(8); PG8_WAIT_L(0); PG8_BAR; PG8_MMA(1, 0, At, B0); PG8_MMA(1, 1, At, B1); PG8_BAR; PG8_SCHED;
            PG8_LDB(B0, 1, 0); PG8_LDB(B1, 1, 1); PG8_SCHED; PG8_LDA(At, 1, 0); PG8_STAGE(PG8_SA(0, 1), a2 + hstepA, voffA);
            PG8_WAIT_V(8); PG8_WAIT_L(0); PG8_BAR; PG8_MMA(0, 0, At, B0); PG8_MMA(0, 1, At, B1); PG8_BAR; PG8_SCHED;
            PG8_LDA(At, 1, 1); PG8_STAGE(PG8_SB(1, 0), b3, voffB); PG8_STAGE(PG8_SB(1, 1), b3 + hstepB, voffB); PG8_STAGE(PG8_SA(1, 0), a3, voffA);
            PG8_WAIT_V(8); PG8_WAIT_L(0); PG8_BAR; PG8_MMA(1, 0, At, B0); PG8_MMA(1, 1, At, B1); PG8_BAR; PG8_SCHED;
            } else {
            PG8_LDB(B0, 0, 0); PG8_SCHED; PG8_LDA(At, 0, 0); PG8_STAGE(PG8_SA(1, 1), a1 + hstepA, voffA);
            PG8_WAIT_L(8); PG8_BAR; PG8_WAIT_L(0); PG8_MMA(0, 0, At, B0); PG8_BAR; PG8_SCHED;
            PG8_LDB(B1, 0, 1); PG8_STAGE(PG8_SB(0, 0), b2, voffB);
            PG8_BAR; PG8_WAIT_L(0); PG8_MMA(0, 1, At, B1); PG8_BAR;
            PG8_LDA(At, 0, 1); PG8_STAGE(PG8_SA(0, 0), a2, voffA);
            PG8_BAR; PG8_WAIT_L(0); PG8_MMA(1, 0, At, B0); PG8_BAR; PG8_SCHED;
            PG8_STAGE(PG8_SB(0, 1), b2 + hstepB, voffB);
            PG8_WAIT_V(6); PG8_BAR; PG8_MMA(1, 1, At, B1); PG8_BAR;
            PG8_LDB(B0, 1, 0); PG8_SCHED; PG8_LDA(At, 1, 0); PG8_STAGE(PG8_SA(0, 1), a2 + hstepA, voffA);
            PG8_WAIT_L(8); PG8_BAR; PG8_WAIT_L(0); PG8_MMA(0, 0, At, B0); PG8_BAR; PG8_SCHED;
            PG8_LDB(B1, 1, 1); PG8_STAGE(PG8_SB(1, 0), b3, voffB);
            PG8_BAR; PG8_WAIT_L(0); PG8_MMA(0, 1, At, B1); PG8_BAR;
            PG8_LDA(At, 1, 1); PG8_STAGE(PG8_SA(1, 0), a3, voffA);
            PG8_BAR; PG8_WAIT_L(0); PG8_MMA(1, 0, At, B0); PG8_BAR; PG8_SCHED;
            PG8_STAGE(PG8_SB(1, 1), b3 + hstepB, voffB);
            PG8_WAIT_V(6); PG8_BAR; PG8_MMA(1, 1, At, B1); PG8_BAR;
            }
        }
        if constexpr (ALIGN_EPI) { if (wr == 0) PG8_BAR; }
        if constexpr (!Epi::AFTER_DRAIN) { E(acc, cur, wr, wc, fr, fq); S.done(cur); }
        if (!has_next) break;
#pragma unroll
        for (int a = 0; a < 2; ++a)
#pragma unroll
            for (int b = 0; b < 2; ++b)
#pragma unroll
                for (int m = 0; m < 4; ++m)
#pragma unroll
                    for (int n = 0; n < 2; ++n) acc[a][b][m][n] = (f32x4){0.f, 0.f, 0.f, 0.f};
        cur = nxt; cA = nA; cB = nB; ++ui;
        if constexpr (ALIGN_EPI) { if (wr == 1) PG8_BAR; }
    }
    PG8_WAIT_V(0);
    if constexpr (!ALIGN_EPI) { if (wr == 0) PG8_BAR; }
    PG8_BAR;
    if constexpr (Epi::AFTER_DRAIN) { E.fused(acc, cur, wr, wc, fr, fq, lds, wid, lane); S.done(cur); }
#undef PG8_ABASE
#undef PG8_SA
#undef PG8_SB
#undef PG8_STAGE
#undef PG8_LDA
#undef PG8_LDB
#undef PG8_MMA
#undef PG8_WAIT_V
#undef PG8_WAIT_L
#undef PG8_BAR
#undef PG8_SCHED
}
}
#define XB_TMO      128
#define XB_XCNT(j)  (256  + 64 * (j))
#define XB_XSUB(j)  (1280 + 64 * (j))
#define XB_XGEN(j)  (2304 + 64 * (j))
#define XB_TOP      3328
#define XB_TOPGEN   3392
#define XCD_BAR_WORDS 3456
#define XB_SPIN_CAP (1u << 18)

__device__ __forceinline__ unsigned xb_ld(unsigned* p)              { return __hip_atomic_load(p, __ATOMIC_RELAXED, __HIP_MEMORY_SCOPE_AGENT); }
__device__ __forceinline__ unsigned xb_add(unsigned* p, unsigned v) { return __hip_atomic_fetch_add(p, v, __ATOMIC_RELAXED, __HIP_MEMORY_SCOPE_AGENT); }
__device__ __forceinline__ unsigned xb_xcc_id() { return (unsigned)__builtin_amdgcn_s_getreg((3 << 11) | 20) & 0xFu; }
#define XB_SPIN(cond, bar) do { unsigned _sp = 0; while (cond) { __builtin_amdgcn_s_sleep(1); \
    if ((++_sp & 255u) == 0u) { if (xb_ld(&(bar)[XB_TMO])) break; if (_sp > XB_SPIN_CAP) { atomicAdd(&(bar)[XB_TMO], 1u); break; } } } } while (0)

struct XcdBarrier {
    unsigned* bar; unsigned x;
    volatile LAS unsigned* st;
};

__device__ __forceinline__ XcdBarrier xcd_barrier_post(unsigned* bar, volatile LAS unsigned* st) {
    XcdBarrier b; b.bar = bar; b.x = xb_xcc_id(); b.st = st;
    if (threadIdx.x == 0) (void)xb_add(&bar[XB_XCNT(b.x)], 1u);
    return b;
}
__device__ __forceinline__ void xcd_barrier_complete(unsigned* bar, unsigned x, unsigned& nloc, unsigned& nx) {
    const unsigned G = gridDim.x * gridDim.y * gridDim.z;
    unsigned sum, cnt, mine, sp = 0u;
    for (;;) {
        sum = 0u; cnt = 0u; mine = 0u;
#pragma unroll
        for (unsigned j = 0; j < 16; ++j) { const unsigned c = xb_ld(&bar[XB_XCNT(j)]); sum += c; cnt += (c > 0u) ? 1u : 0u; mine = (j == x) ? c : mine; }
        if (sum == G) break;
        __builtin_amdgcn_s_sleep(1);
        if ((++sp & 255u) == 0u) { if (xb_ld(&bar[XB_TMO])) break; if (sp > XB_SPIN_CAP) { atomicAdd(&bar[XB_TMO], 1u); break; } }
    }
    nloc = mine > 0u ? mine : 1u; nx = cnt > 0u ? cnt : 1u;
}

__device__ __forceinline__ void xcd_barrier(const XcdBarrier& b) {
    asm volatile("s_waitcnt vmcnt(0)" ::: "memory");
    __syncthreads();
    if (threadIdx.x == 0) {
        unsigned* bar = b.bar;
        __builtin_amdgcn_s_waitcnt(0);
        unsigned nloc = b.st[0], nx = b.st[1];
        if (nloc == 0u) { xcd_barrier_complete(bar, b.x, nloc, nx); b.st[0] = nloc; b.st[1] = nx; }
        const unsigned old = xb_add(&bar[XB_XSUB(b.x)], 1u);
        const unsigned gen = old / nloc;
        if (old + 1u == (gen + 1u) * nloc) {
            __builtin_amdgcn_fence(__ATOMIC_RELEASE, "agent");
            asm volatile("s_waitcnt vmcnt(0)" ::: "memory");
            const unsigned og = xb_add(&bar[XB_TOP], 1u);
            const unsigned tg = og / nx;
            if (og + 1u == (tg + 1u) * nx) xb_add(&bar[XB_TOPGEN], 1u);
            else XB_SPIN(xb_ld(&bar[XB_TOPGEN]) == tg, bar);
            __builtin_amdgcn_fence(__ATOMIC_ACQUIRE, "agent");
            xb_add(&bar[XB_XGEN(b.x)], 1u);
            asm volatile("s_waitcnt vmcnt(0)" ::: "memory");
        } else {
            XB_SPIN(xb_ld(&bar[XB_XGEN(b.x)]) == gen, bar);
            __builtin_amdgcn_fence(__ATOMIC_ACQUIRE, "agent");
            asm volatile("s_waitcnt vmcnt(0)" ::: "memory");
        }
    }
    __syncthreads();
}
struct Frame {
    LAS unsigned char* lds;
    volatile LAS unsigned* MISC;
    gu32* ctl;
    int tid, lane, wave;
    int vcu, G;
    unsigned char* ws;
    const float* in[21];
    float* out;
};
__device__ __forceinline__ int prev_row(int r) { return r == SEQ ? -1 : (r == 0 ? LTOK - 1 : r - 1); }
__device__ __forceinline__ const float* base_row(const Frame& F, int r) { return r < SEQ ? F.in[0] + (size_t)r * DM : F.in[1] + (size_t)(r - SEQ) * DM; }

__device__ __forceinline__ void transpose_item(const float* W, int N, bf16* WT, int ldk, int k0, int n0, int drow0, LAS float* scr, int lane) {
#pragma unroll 8
    for (int i = 0; i < 32; ++i) { const int kk = 2 * i + (lane >> 5); scr[kk * 33 + (lane & 31)] = W[(size_t)(k0 + kk) * N + n0 + (lane & 31)]; }
    LDS_WAIT(); asm volatile("" ::: "memory");
    const int c = lane & 7;
#pragma unroll
    for (int j = 0; j < 4; ++j) { const int n = (lane >> 3) + 8 * j; const LAS float* s = scr + (8 * c) * 33 + n;
        v4u o; o.x = pk2(s[0 * 33], s[1 * 33]); o.y = pk2(s[2 * 33], s[3 * 33]); o.z = pk2(s[4 * 33], s[5 * 33]); o.w = pk2(s[6 * 33], s[7 * 33]);
        *(GAS v4u*)(WT + (size_t)(drow0 + n) * ldk + k0 + 8 * c) = o; }
    LDS_WAIT(); asm volatile("" ::: "memory");
}
__device__ __forceinline__ void tr_plain(const float* W, int K, int N, bf16* WT, int item, LAS float* scr, int lane) {
    const int nblk = N / 32, kb = item / nblk, nb = item % nblk; transpose_item(W, N, WT, K, 64 * kb, 32 * nb, 32 * nb, scr, lane);
}
__device__ __forceinline__ void tr_gu(const float* W, bf16* WT, int item, LAS float* scr, int lane) {
    const int nblk = (2 * DFF) / 32, kb = item / nblk, nb = item % nblk, n0 = 32 * nb; const int isup = n0 >= DFF, c0 = isup ? n0 - DFF : n0;
    transpose_item(W, 2 * DFF, WT, DM, 64 * kb, n0, 256 * (c0 >> 7) + (c0 & 127) + (isup ? 128 : 0), scr, lane);
}
__device__ __forceinline__ void tr_lru(const float* W, bf16* WT, int isx, int item, LAS float* scr, int lane) {
    const int h = item >> 5, r = item & 31, kb = r >> 3, nb = r & 7, j0 = 32 * nb;
    transpose_item(W + (size_t)h * 65536, 256, WT, 256, 64 * kb, j0, 256 * (2 * h + (j0 >> 7)) + (j0 & 127) + (isx ? 128 : 0), scr, lane);
}
__device__ __forceinline__ void rms_row_to_bf16(const Frame& F, const float* xrow, const float* w, bf16* orow) {
    const GAS f32x4* xr = (const GAS f32x4*)xrow + F.lane; const GAS f32x4* wr = (const GAS f32x4*)w + F.lane;
    f32x4 v[16]; float s = 0.f;
#pragma unroll
    for (int j = 0; j < 16; ++j) { v[j] = xr[64 * j]; s += (v[j].x * v[j].x + v[j].y * v[j].y) + (v[j].z * v[j].z + v[j].w * v[j].w); }
    const float rstd = 1.0f / sqrtf(wave_sum(s) * (1.f / DM) + NORM_EPS);
    GAS v2u* o8 = (GAS v2u*)orow + F.lane;
#pragma unroll
    for (int j = 0; j < 16; ++j) { const f32x4 g = wr[64 * j]; v2u o; o.x = pk2(v[j].x * rstd * g.x, v[j].y * rstd * g.y); o.y = pk2(v[j].z * rstd * g.z, v[j].w * rstd * g.w); o8[64 * j] = o; }
}
__device__ __forceinline__ void p0_prologue(Frame& F) {
    LAS float* scr = (LAS float*)(F.lds + RING_OFF + F.wave * 16384);
    const int gw = F.vcu * NWAVES + F.wave, NGW = F.G * NWAVES;
    constexpr int I_INE = (DM / 64) * (EVEN_IN / 32), I_44 = (DM / 64) * (DM / 32), I_INO = (DM / 64) * (8192 / 32), I_LRU = 16 * 32, I_GU = (DM / 64) * (2 * DFF / 32), I_D = (DFF / 64) * (DM / 32);
    constexpr int NITEMS = I_INE + I_44 + I_INO + 2 * I_LRU + I_44 + 2 * I_GU + 2 * I_D;
    unsigned char* ws = F.ws;
    for (int it = gw; it < NITEMS; it += NGW) {
        int r = it;
        if (r < I_INE) { tr_plain(F.in[3], DM, EVEN_IN, (bf16*)(ws + WS_WIN_E), r, scr, F.lane); continue; } r -= I_INE;
        if (r < I_44) { tr_plain(F.in[7], DM, DM, (bf16*)(ws + WS_WOUT_E), r, scr, F.lane); continue; } r -= I_44;
        if (r < I_INO) { tr_plain(F.in[8], DM, 8192, (bf16*)(ws + WS_WIN_O), r, scr, F.lane); continue; } r -= I_INO;
        if (r < I_LRU) { tr_lru(F.in[11], (bf16*)(ws + WS_WG), 0, r, scr, F.lane); continue; } r -= I_LRU;
        if (r < I_LRU) { tr_lru(F.in[13], (bf16*)(ws + WS_WG), 1, r, scr, F.lane); continue; } r -= I_LRU;
        if (r < I_44) { tr_plain(F.in[16], DM, DM, (bf16*)(ws + WS_WOUT_O), r, scr, F.lane); continue; } r -= I_44;
        if (r < 2 * I_GU) { const int L = r / I_GU; tr_gu(F.in[17] + (size_t)L * DM * 2 * DFF, (bf16*)(ws + WS_WGU + (size_t)L * SZ_WGU), r % I_GU, scr, F.lane); continue; } r -= 2 * I_GU;
        { const int L = r / I_D; tr_plain(F.in[20] + (size_t)L * DFF * DM, DFF, DM, (bf16*)(ws + WS_WD + (size_t)L * SZ_WD), r % I_D, scr, F.lane); }
    }
    for (int c = F.vcu * 512 + F.tid; c < DM; c += F.G * 512) { const float p = F.in[15][c]; ((float*)(ws + WS_LS8))[c] = -8.0f * (fmaxf(-p, 0.f) + log1pf(expf(-fabsf(p)))); }
    for (int m = gw; m < LTOK; m += NGW) rms_row_to_bf16(F, base_row(F, m), F.in[2], (bf16*)(ws + WS_XN) + (size_t)m * DM);
}

__device__ __forceinline__ void norm_pass(const Frame& F, const float* src, int base_is_input, const float* hin, const float* wA, const float* wB, float* hout, bf16* xn, int final_out) {
    const int gw = F.vcu * NWAVES + F.wave, NGW = F.G * NWAVES;
    for (int r = gw; r < LTOK; r += NGW) {
        if (final_out && r >= SEQ) continue;
        const GAS f32x4* sr = (const GAS f32x4*)(src + (size_t)r * DM) + F.lane;
        const GAS f32x4* br = (const GAS f32x4*)(base_is_input ? base_row(F, r) : hin + (size_t)r * DM) + F.lane;
        const GAS f32x4* wa = (const GAS f32x4*)wA + F.lane;
        f32x4 v[16]; float s = 0.f;
#pragma unroll
        for (int j = 0; j < 16; ++j) { v[j] = sr[64 * j]; s += (v[j].x * v[j].x + v[j].y * v[j].y) + (v[j].z * v[j].z + v[j].w * v[j].w); }
        const float rstd = 1.0f / sqrtf(wave_sum(s) * (1.f / DM) + NORM_EPS);
        GAS f32x4* ho = (GAS f32x4*)(hout + (size_t)r * DM) + F.lane;
        float s2 = 0.f;
#pragma unroll
        for (int j = 0; j < 16; ++j) { const f32x4 g = wa[64 * j], b = br[64 * j]; v[j] = b + v[j] * rstd * g; ho[64 * j] = v[j]; s2 += (v[j].x * v[j].x + v[j].y * v[j].y) + (v[j].z * v[j].z + v[j].w * v[j].w); if ((j & 3) == 3) asm volatile("" ::: "memory"); }
        if (xn) {
            const float rstd2 = 1.0f / sqrtf(wave_sum(s2) * (1.f / DM) + NORM_EPS);
            const GAS f32x4* wb = (const GAS f32x4*)wB + F.lane; GAS v2u* o8 = (GAS v2u*)(xn + (size_t)r * DM) + F.lane;
#pragma unroll
            for (int j = 0; j < 16; ++j) { const f32x4 g = wb[64 * j]; v2u o; o.x = pk2(v[j].x * rstd2 * g.x, v[j].y * rstd2 * g.y); o.y = pk2(v[j].z * rstd2 * g.z, v[j].w * rstd2 * g.w); o8[64 * j] = o; if ((j & 3) == 3) asm volatile("" ::: "memory"); }
        }
    }
}

__device__ __forceinline__ void ffn_act_pass(const Frame& F, const float* G, const bf16* U, const float* cw, const float* cb, bf16* ACT) {
    const int gw = F.vcu * NWAVES + F.wave, NGW = F.G * NWAVES;
    constexpr int NCG = DFF / 256, NRB = LTOK / 16;
    for (int it = gw; it < NCG * NRB; it += NGW) {
        const int rb = it / NCG, cg = it % NCG, r0 = 16 * rb, c = cg * 256 + 4 * F.lane;
        const f32x4 w0 = *(const GAS f32x4*)(cw + c), w1 = *(const GAS f32x4*)(cw + DFF + c), w2 = *(const GAS f32x4*)(cw + 2 * DFF + c), bb = *(const GAS f32x4*)(cb + c);
        f32x4 gm2 = (f32x4){0.f, 0.f, 0.f, 0.f}, gm1 = gm2;
        if (r0 != SEQ) { const int p1 = prev_row(r0), p2 = prev_row(p1); gm1 = *(const GAS f32x4*)(G + (size_t)p1 * DFF + c); gm2 = *(const GAS f32x4*)(G + (size_t)p2 * DFF + c); }
#pragma unroll 4
        for (int i = 0; i < 16; ++i) { const size_t off = (size_t)(r0 + i) * DFF + c;
            const f32x4 g = *(const GAS f32x4*)(G + off); const v2u uu = *(const GAS v2u*)(U + off);
            const f32x4 v = bb + w0 * gm2 + w1 * gm1 + w2 * g;
            v2u o; o.x = pk2(fgelu_tanh(v.x) * bflo(uu.x), fgelu_tanh(v.y) * bfhi(uu.x)); o.y = pk2(fgelu_tanh(v.z) * bflo(uu.y), fgelu_tanh(v.w) * bfhi(uu.y));
            *(GAS v2u*)(ACT + off) = o; gm2 = gm1; gm1 = g; }
    }
}

__device__ __forceinline__ void lru_conv_pass(const Frame& F, const float* X, const float* cw, const float* cb, float* XC, bf16* XCB) {
    const int gw = F.vcu * NWAVES + F.wave, NGW = F.G * NWAVES;
    constexpr int NCG = DM / 256, NRB = LTOK / 16;
    for (int it = gw; it < NCG * NRB; it += NGW) {
        const int rb = it / NCG, cg = it % NCG, r0 = 16 * rb, c = cg * 256 + 4 * F.lane;
        const f32x4 w0 = *(const GAS f32x4*)(cw + c), w1 = *(const GAS f32x4*)(cw + DM + c), w2 = *(const GAS f32x4*)(cw + 2 * DM + c), w3 = *(const GAS f32x4*)(cw + 3 * DM + c), bb = *(const GAS f32x4*)(cb + c);
        f32x4 x3 = (f32x4){0.f, 0.f, 0.f, 0.f}, x2 = x3, x1 = x3;
        if (r0 != SEQ) { const int p1 = prev_row(r0), p2 = prev_row(p1), p3 = prev_row(p2);
            x1 = *(const GAS f32x4*)(X + (size_t)p1 * DM + c); x2 = *(const GAS f32x4*)(X + (size_t)p2 * DM + c); x3 = *(const GAS f32x4*)(X + (size_t)p3 * DM + c); }
#pragma unroll 4
        for (int i = 0; i < 16; ++i) { const size_t off = (size_t)(r0 + i) * DM + c;
            const f32x4 x = *(const GAS f32x4*)(X + off);
            const f32x4 v = bb + w0 * x3 + w1 * x2 + w2 * x1 + w3 * x;
            *(GAS f32x4*)(XC + off) = v; v2u o; o.x = pk2(v.x, v.y); o.y = pk2(v.z, v.w); *(GAS v2u*)(XCB + off) = o;
            x3 = x2; x2 = x1; x1 = x; }
    }
}

__device__ __forceinline__ void seg_rows(int s, int& r0, int& n) { if (s == 0) { r0 = SEQ; n = NMETA; } else { r0 = 64 * (s - 1); n = 64; } }
__device__ __forceinline__ void lru_scan1(const Frame& F, const float* A, const float* B, float* CA, float* CB) {
    const int gw = F.vcu * NWAVES + F.wave, NGW = F.G * NWAVES;
    for (int it = gw; it < NCHUNK * 16; it += NGW) {
        const int s = it >> 4, c = (it & 15) * 256 + 4 * F.lane; int r0, n; seg_rows(s, r0, n);
        f32x4 pa = (f32x4){1.f, 1.f, 1.f, 1.f}, h = (f32x4){0.f, 0.f, 0.f, 0.f};
#pragma unroll 8
        for (int i = 0; i < n; ++i) { const size_t off = (size_t)(r0 + i) * DM + c; const f32x4 a = *(const GAS f32x4*)(A + off), b = *(const GAS f32x4*)(B + off); h = a * h + b; pa = pa * a; }
        *(GAS f32x4*)(CA + (size_t)s * DM + c) = pa; *(GAS f32x4*)(CB + (size_t)s * DM + c) = h;
    }
}
__device__ __forceinline__ void lru_scan2(const Frame& F, const float* A, const float* B, const float* CA, const float* CB, const bf16* Y, bf16* LO) {
    const int gw = F.vcu * NWAVES + F.wave, NGW = F.G * NWAVES;
    for (int it = gw; it < NCHUNK * 16; it += NGW) {
        const int s = it >> 4, c = (it & 15) * 256 + 4 * F.lane; int r0, n; seg_rows(s, r0, n);
        f32x4 h = (f32x4){0.f, 0.f, 0.f, 0.f};
#pragma unroll 8
        for (int j = 0; j < s; ++j) { const f32x4 a = *(const GAS f32x4*)(CA + (size_t)j * DM + c), b = *(const GAS f32x4*)(CB + (size_t)j * DM + c); h = a * h + b; }
#pragma unroll 8
        for (int i = 0; i < n; ++i) { const size_t off = (size_t)(r0 + i) * DM + c; const f32x4 a = *(const GAS f32x4*)(A + off), b = *(const GAS f32x4*)(B + off); const v2u yy = *(const GAS v2u*)(Y + off);
            h = a * h + b; v2u o; o.x = pk2(h.x * bflo(yy.x), h.y * bfhi(yy.x)); o.y = pk2(h.z * bflo(yy.y), h.w * bfhi(yy.y)); *(GAS v2u*)(LO + off) = o; }
    }
}
__device__ __forceinline__ f32x4 mma_nt(const LAS bf16* A, int lda, const LAS bf16* B, int ldb, int nks, f32x4 acc, int lane) {
    const LAS bf16* ap = A + (lane & 15) * lda + 8 * (lane >> 4); const LAS bf16* bp = B + (lane & 15) * ldb + 8 * (lane >> 4);
    for (int ks = 0; ks < nks; ++ks) { const bf16x8 a = *(const LAS bf16x8*)(ap + 32 * ks), b = *(const LAS bf16x8*)(bp + 32 * ks); acc = __builtin_amdgcn_mfma_f32_16x16x32_bf16(a, b, acc, 0, 0, 0); }
    return acc;
}
__device__ __forceinline__ int hg_row(int n, int t) { return n == 0 ? (t < 48 ? -1 : SEQ + t - 48) : 64 * (n - 1) + t; }
__device__ __forceinline__ void hg_load_vt(const bf16* VA, int hh, int n, LAS bf16* VT, int tid) {
    const int t = tid >> 3, vs = (tid & 7) * 16, r = hg_row(n, t);
    v4u a = (v4u){0u, 0u, 0u, 0u}, b = a;
    if (r >= 0) { const GAS v4u* p = (const GAS v4u*)(VA + (size_t)r * 2048 + hh * 128 + vs); a = p[0]; b = p[1]; }
    const unsigned w[8] = {a.x, a.y, a.z, a.w, b.x, b.y, b.z, b.w};
#pragma unroll
    for (int j = 0; j < 8; ++j) { VT[(vs + 2 * j) * 72 + t] = (bf16)(w[j] & 0xffffu); VT[(vs + 2 * j + 1) * 72 + t] = (bf16)(w[j] >> 16); }
}
__device__ __forceinline__ void hgrn_h1(const Frame& F, const float* GL, const bf16* VA, float* US, float* DS) {
    LAS bf16* KT = (LAS bf16*)(F.lds + 0);
    LAS bf16* VT = (LAS bf16*)(F.lds + 18432);
    LAS float* TOT = (LAS float*)(F.lds + 36864);
    const int tid = F.tid, lane = F.lane, w = F.wave, k = tid & 127, sc = tid >> 7;
    for (int unit = F.vcu; unit < A_HEADS * NCHUNK; unit += F.G) {
        const int hh = unit / NCHUNK, n = unit % NCHUNK;
        float g[16], cs[16]; float run = 0.f;
#pragma unroll
        for (int i = 0; i < 16; ++i) { const int r = hg_row(n, 16 * sc + i); g[i] = r >= 0 ? GL[(size_t)r * 2048 + hh * 128 + k] : 0.f; }
#pragma unroll
        for (int i = 0; i < 16; ++i) { run += g[i]; cs[i] = run; }
        TOT[sc * 128 + k] = run;
        hg_load_vt(VA, hh, n, VT, tid);
        __syncthreads();
        float off = 0.f, total = 0.f;
#pragma unroll
        for (int j = 0; j < 4; ++j) { const float tj = TOT[j * 128 + k]; off += (j < sc) ? tj : 0.f; total += tj; }
        unsigned pk[8];
#pragma unroll
        for (int i = 0; i < 8; ++i) { const float e0 = (1.0f - fexp(g[2 * i])) * fexp(total - off - cs[2 * i]), e1 = (1.0f - fexp(g[2 * i + 1])) * fexp(total - off - cs[2 * i + 1]); pk[i] = pk2(e0, e1); }
        *(LAS v4u*)(KT + k * 72 + 16 * sc) = (v4u){pk[0], pk[1], pk[2], pk[3]}; *(LAS v4u*)(KT + k * 72 + 16 * sc + 8) = (v4u){pk[4], pk[5], pk[6], pk[7]};
        if (sc == 0) DS[(size_t)unit * 128 + k] = fexp(total);
        __syncthreads();
        float* up = US + (size_t)unit * 16384 + (size_t)(16 * w + 4 * (lane >> 4)) * 128 + (lane & 15);
#pragma unroll
        for (int vb = 0; vb < 8; ++vb) { f32x4 acc = (f32x4){0.f, 0.f, 0.f, 0.f}; acc = mma_nt(KT + 16 * w * 72, 72, VT + 16 * vb * 72, 72, 2, acc, lane);
#pragma unroll
            for (int rg = 0; rg < 4; ++rg) up[rg * 128 + 16 * vb] = acc[rg]; }
        __syncthreads();
    }
}
__device__ __forceinline__ void hgrn_h2(const Frame& F, float* US, const float* DS) {
    const int e = F.vcu * 512 + F.tid;
    for (int idx = e; idx < A_HEADS * 16384; idx += F.G * 512) {
        const int hh = idx >> 14, kv = idx & 16383, k = kv >> 7; float S = 0.f;
        float* p = US + (size_t)hh * NCHUNK * 16384 + kv; const float* d = DS + (size_t)hh * NCHUNK * 128 + k;
#pragma unroll 4
        for (int n = 0; n < NCHUNK; ++n) { const float u = p[(size_t)n * 16384], dd = d[n * 128]; p[(size_t)n * 16384] = S; S = dd * S + u; }
    }
}
__device__ __forceinline__ void hgrn_h3(const Frame& F, const float* QA, const float* GL, const float* GT, const bf16* VA, const float* US, const float* gnw, bf16* MIX) {
    LAS bf16* QS = (LAS bf16*)(F.lds + 0);
    LAS bf16* KS = (LAS bf16*)(F.lds + 17408);
    LAS bf16* VT = (LAS bf16*)(F.lds + 60928);
    LAS bf16* P  = (LAS bf16*)(F.lds + 79360);
    LAS float* TOT = (LAS float*)(F.lds + 88576);
    LAS float* OB = (LAS float*)(F.lds + 90624);
    const int tid = F.tid, lane = F.lane, w = F.wave, k = tid & 127, sc = tid >> 7;
    for (int unit = F.vcu; unit < A_HEADS * NCHUNK; unit += F.G) {
        const int hh = unit / NCHUNK, n = unit % NCHUNK;
        float g[16], q[16], cs[16]; float run = 0.f;
#pragma unroll
        for (int i = 0; i < 16; ++i) { const int r = hg_row(n, 16 * sc + i); const size_t o = (size_t)(r >= 0 ? r : 0) * 2048 + hh * 128 + k; g[i] = r >= 0 ? GL[o] : 0.f; q[i] = r >= 0 ? QA[o] : 0.f; }
#pragma unroll
        for (int i = 0; i < 16; ++i) { run += g[i]; cs[i] = run; }
        TOT[sc * 128 + k] = run;
        hg_load_vt(VA, hh, n, VT, tid);
        for (int i = tid; i < 64 * 72 / 2; i += 512) ((LAS unsigned*)P)[i] = 0u;
        __syncthreads();
        float R[4]; { float a = 0.f;
#pragma unroll
            for (int j = 0; j < 4; ++j) { R[j] = a; a += TOT[j * 128 + k]; } }
        float off = 0.f;
#pragma unroll
        for (int j = 0; j < 4; ++j) off = (j == sc) ? R[j] : off;
#pragma unroll
        for (int i = 0; i < 16; ++i) QS[(16 * sc + i) * 136 + k] = (bf16)f2bf(q[i] * fexp(cs[i]));
#pragma unroll
        for (int i2 = 0; i2 < 4; ++i2) if (i2 >= sc) { const int base = (i2 * (i2 + 1) / 2) * 16; const float rr = R[i2] - off;
#pragma unroll
            for (int i = 0; i < 16; ++i) KS[(base + 16 * sc + i) * 136 + k] = (bf16)f2bf((1.0f - fexp(g[i])) * fexp(rr - cs[i])); }
        __syncthreads();
        for (int b = w; b < 10; b += 8) { const int i = b >= 6 ? 3 : (b >= 3 ? 2 : (b >= 1 ? 1 : 0)), j = b - i * (i + 1) / 2, base = (i * (i + 1) / 2) * 16;
            f32x4 acc = (f32x4){0.f, 0.f, 0.f, 0.f}; acc = mma_nt(QS + 16 * i * 136, 136, KS + (base + 16 * j) * 136, 136, 4, acc, lane);
#pragma unroll
            for (int rg = 0; rg < 4; ++rg) { const int tr = 4 * (lane >> 4) + rg, sccol = lane & 15; const float v = (j < i || sccol <= tr) ? acc[rg] : 0.f; P[(16 * i + tr) * 72 + 16 * j + sccol] = (bf16)f2bf(v); } }
        __syncthreads();
#pragma unroll
        for (int i = 0; i < 16; ++i) QS[(16 * sc + i) * 136 + k] = (bf16)f2bf(q[i] * fexp(cs[i] + off));
        { LAS bf16* ST = KS; const int kk = tid >> 2, vq = tid & 3; const float* sp = US + (size_t)unit * 16384 + (size_t)kk * 128 + vq * 32;
#pragma unroll
            for (int j = 0; j < 8; ++j) { const f32x4 s = *(const GAS f32x4*)(sp + 4 * j);
#pragma unroll
                for (int e = 0; e < 4; ++e) ST[(vq * 32 + 4 * j + e) * 136 + kk] = (bf16)f2bf(s[e]); } }
        __syncthreads();
        { const LAS bf16* ST = KS; const int tb = w >> 1, vb0 = 4 * (w & 1);
#pragma unroll
            for (int vb = 0; vb < 4; ++vb) { f32x4 acc = (f32x4){0.f, 0.f, 0.f, 0.f};
                acc = mma_nt(QS + 16 * tb * 136, 136, ST + 16 * (vb0 + vb) * 136, 136, 4, acc, lane);
                acc = mma_nt(P + 16 * tb * 72, 72, VT + 16 * (vb0 + vb) * 72, 72, 2, acc, lane);
#pragma unroll
                for (int rg = 0; rg < 4; ++rg) OB[(16 * tb + 4 * (lane >> 4) + rg) * 128 + 16 * (vb0 + vb) + (lane & 15)] = acc[rg]; } }
        __syncthreads();
        for (int i = 0; i < 8; ++i) { const int t = 8 * w + i, r = hg_row(n, t); if (r < 0) continue;
            const f32x2 o = *(const LAS f32x2*)(OB + t * 128 + 2 * lane); const float ss = wave_sum(o.x * o.x + o.y * o.y); const float rstd = 1.0f / sqrtf(ss * (1.f / 128.f) + NORM_EPS);
            const f32x2 gt = *(const GAS f32x2*)(GT + (size_t)r * 2048 + hh * 128 + 2 * lane), gw2 = *(const GAS f32x2*)(gnw + 2 * lane);
            *(GAS unsigned*)(MIX + (size_t)r * DM + hh * 128 + 2 * lane) = pk2(o.x * rstd * gw2.x * gt.x, o.y * rstd * gw2.y * gt.y); }
        __syncthreads();
    }
}
__device__ __forceinline__ void attn_phase(const Frame& F, const bf16* QB, const bf16* KB, const bf16* VB, const float* sinks, bf16* MIX) {
    LAS bf16* KL = (LAS bf16*)(F.lds + 0);
    LAS bf16* VT = (LAS bf16*)(F.lds + 41472);
    const int tid = F.tid, lane = F.lane, w = F.wave, g = lane >> 4, ql = lane & 15;
    for (int unit = F.vcu; unit < 260; unit += F.G) {
        const bool meta = unit >= 256; const int kvh = meta ? unit - 256 : unit >> 6, jb = meta ? 0 : unit & 63;
        for (int pass = 0; pass < 5; ++pass) { const int key = pass * 64 + (tid >> 3), d8 = (tid & 7) * 8; if (key >= 288) break;
            int r = -1;
            if (key < 128) r = (!meta && jb >= 1) ? 128 * (jb - 1) + key : -1; else if (key < 256) r = !meta ? 128 * jb + key - 128 : -1; else if (key < 272) r = SEQ + key - 256;
            v4u kk = (v4u){0u, 0u, 0u, 0u}, vv = kk;
            if (r >= 0) { kk = *(const GAS v4u*)(KB + (size_t)r * 256 + kvh * 64 + d8); vv = *(const GAS v4u*)(VB + (size_t)r * 256 + kvh * 64 + d8); }
            *(LAS v4u*)(KL + key * 72 + d8) = kk;
            const unsigned wv[4] = {vv.x, vv.y, vv.z, vv.w};
#pragma unroll
            for (int j = 0; j < 4; ++j) { VT[(d8 + 2 * j) * 296 + key] = (bf16)(wv[j] & 0xffffu); VT[(d8 + 2 * j + 1) * 296 + key] = (bf16)(wv[j] >> 16); } }
        __syncthreads();
        if (!meta || w == 0) {
            const int qi = meta ? ql : 16 * w + ql; const int qrow = meta ? SEQ + ql : 128 * jb + qi;
            for (int g8 = 0; g8 < 8; ++g8) { const int head = kvh * 8 + g8;
                const GAS bf16x8* qp = (const GAS bf16x8*)(QB + (size_t)qrow * 2048 + head * 64 + 8 * g);
                const bf16x8 q0 = qp[0], q1 = qp[4];
                f32x4 s[18]; const float sk = sinks[head]; float mx = sk;
#pragma unroll
                for (int kb = 0; kb < 18; ++kb) { f32x4 acc = (f32x4){0.f, 0.f, 0.f, 0.f}; const LAS bf16* kp = KL + (16 * kb + ql) * 72 + 8 * g;
                    acc = __builtin_amdgcn_mfma_f32_16x16x32_bf16(*(const LAS bf16x8*)kp, q0, acc, 0, 0, 0); acc = __builtin_amdgcn_mfma_f32_16x16x32_bf16(*(const LAS bf16x8*)(kp + 32), q1, acc, 0, 0, 0);
#pragma unroll
                    for (int rg = 0; rg < 4; ++rg) { const int kk = 16 * kb + 4 * g + rg; bool ok;
                        if (meta) ok = kk >= 256 && kk < 272 && (kk - 256) <= qi; else ok = kk < 128 ? (jb >= 1 && kk >= qi + 1) : (kk < 256 ? (kk - 128 <= qi) : kk < 272);
                        acc[rg] = ok ? acc[rg] * 0.125f : -1e30f; mx = fmaxf(mx, acc[rg]); }
                    s[kb] = acc; if (kb & 1) __builtin_amdgcn_sched_barrier(0); }
                mx = fmaxf(mx, __shfl_xor(mx, 16)); mx = fmaxf(mx, __shfl_xor(mx, 32));
                float l = 0.f; bf16x8 pf[9];
#pragma unroll
                for (int pp = 0; pp < 9; ++pp) { float e[8];
#pragma unroll
                    for (int rg = 0; rg < 4; ++rg) { e[rg] = fexp(s[2 * pp][rg] - mx); e[4 + rg] = fexp(s[2 * pp + 1][rg] - mx); }
#pragma unroll
                    for (int j = 0; j < 8; ++j) l += e[j];
                    const v4u pw = (v4u){pk2(e[0], e[1]), pk2(e[2], e[3]), pk2(e[4], e[5]), pk2(e[6], e[7])}; pf[pp] = __builtin_bit_cast(bf16x8, pw); }
                l += __shfl_xor(l, 16); l += __shfl_xor(l, 32); l += fexp(sk - mx);
                const float inv = 1.0f / l;
#pragma unroll 1
                for (int db = 0; db < 4; ++db) { f32x4 acc = (f32x4){0.f, 0.f, 0.f, 0.f}; const LAS bf16* vp = VT + (16 * db + ql) * 296 + 4 * g;
#pragma unroll
                    for (int pp = 0; pp < 9; ++pp) { const v2u lo = *(const LAS v2u*)(vp + 32 * pp), hi = *(const LAS v2u*)(vp + 32 * pp + 16); const v4u av = (v4u){lo.x, lo.y, hi.x, hi.y};
                        acc = __builtin_amdgcn_mfma_f32_16x16x32_bf16(__builtin_bit_cast(bf16x8, av), pf[pp], acc, 0, 0, 0); }
                    v2u o; o.x = pk2(acc[0] * inv, acc[1] * inv); o.y = pk2(acc[2] * inv, acc[3] * inv);
                    *(GAS v2u*)(MIX + (size_t)qrow * DM + 2048 + head * 64 + 16 * db + 4 * g) = o; }
            }
        }
        __syncthreads();
    }
}
#ifndef MK_SINGLE
#define MK_SINGLE 0
#endif
constexpr int N_PHASES = 22;
#ifndef PHMASK
#define PHMASK 0xffffffu
#endif
#define EN(k) (((PHMASK) >> ((k) % 24)) & 1u)
#define IN(k) (EN(k) && lo <= (k) && (k) < hi)
#define SEAM(k) do { if (IN(k) && IN((k) + 1)) xcd_barrier(bar); } while (0)
template <int L> __device__ __forceinline__ void layer_tail(Frame& F, const XcdBarrier& bar, int lo, int hi, const bf16* mixA) {
    constexpr int pb = (L == 0) ? 5 : 16;
    unsigned char* ws = F.ws; bf16* XN = (bf16*)(ws + WS_XN); float* H = (float*)(ws + WS_H); float* Y = (float*)(ws + WS_Y); unsigned char* ar = ws + WS_AR; const float* nw = F.in[2];
        if (IN(pb)) {
            pg8::Gemm g{mixA, (const bf16*)(ws + (L == 0 ? WS_WOUT_E : WS_WOUT_O)), MP, DM, DM, DM, DM, -1}; pg8::StaticOrder S; S.init(MP, DM, F.G, (int)blockIdx.x);
            pg8::EpiF32 E{Y, DM};
            pg8::gemm_phase<pg8::EpiF32, pg8::StaticOrder, true, true>(F.lds + RING_OFF, g, S, E);
        } SEAM(pb);
        if (IN(pb + 1)) { norm_pass(F, Y, L == 0, H, nw + (size_t)(L * 4 + 1) * DM, nw + (size_t)(L * 4 + 2) * DM, H, XN, 0); } SEAM(pb + 1);
        if (IN(pb + 2)) {
            pg8::Gemm g{XN, (const bf16*)(ws + WS_WGU + (size_t)L * SZ_WGU), MP, 2 * DFF, DM, DM, DM, -1}; pg8::StaticOrder S; S.init(MP, 2 * DFF, F.G, (int)blockIdx.x);
            pg8::EpiGU E{(float*)(ar + AR_G), (bf16*)(ar + AR_U)};
            pg8::gemm_phase<pg8::EpiGU, pg8::StaticOrder, true, true>(F.lds + RING_OFF, g, S, E);
        } SEAM(pb + 2);
        if (IN(pb + 3)) { ffn_act_pass(F, (const float*)(ar + AR_G), (const bf16*)(ar + AR_U), F.in[18] + (size_t)L * 3 * DFF, F.in[19] + (size_t)L * DFF, (bf16*)(ar + AR_ACT)); } SEAM(pb + 3);
        if (IN(pb + 4)) {
            pg8::Gemm g{(const bf16*)(ar + AR_ACT), (const bf16*)(ws + WS_WD + (size_t)L * SZ_WD), MP, DM, DFF, DFF, DFF, -1}; pg8::StaticOrder S; S.init(MP, DM, F.G, (int)blockIdx.x);
            pg8::EpiF32 E{Y, DM};
            pg8::gemm_phase<pg8::EpiF32, pg8::StaticOrder, true, true>(F.lds + RING_OFF, g, S, E);
        } SEAM(pb + 4);
        if (IN(pb + 5)) {
            if (L == 0) norm_pass(F, Y, 0, H, nw + (size_t)3 * DM, nw + (size_t)4 * DM, H, XN, 0);
            else norm_pass(F, Y, 0, H, nw + (size_t)7 * DM, nullptr, F.out, nullptr, 1);
        }
        if (L == 0) SEAM(pb + 5);
}
struct Args { const float* in[21]; float* out; unsigned char* ws; int ph_lo, ph_hi; };
__global__ void __launch_bounds__(NWAVES * 64, 2) fwd_kernel(Args args) {
    extern __shared__ __attribute__((aligned(16))) unsigned char lds[];
    Frame F;
    F.lds = (LAS unsigned char*)lds;
    F.MISC = (volatile LAS unsigned*)(F.lds + MISC_OFF);
    F.tid = threadIdx.x; F.lane = F.tid & 63; F.wave = __builtin_amdgcn_readfirstlane(F.tid >> 6);
    F.G = gridDim.x; { const int bx = blockIdx.x; F.vcu = (F.G % 8 == 0) ? (bx % 8) * (F.G / 8) + bx / 8 : bx; }
    unsigned char* ws = args.ws; F.ws = ws;
    F.ctl = (gu32*)(ws + WS_CTL);
#pragma unroll
    for (int i = 0; i < 21; ++i) F.in[i] = args.in[i];
    F.out = args.out;
    for (int u = F.tid; u < (LDS_BYTES - LDSCTL_OFF) / 4; u += NWAVES * 64) ((LAS unsigned*)(F.lds + LDSCTL_OFF))[u] = 0u;
    __syncthreads();
    const int lo = args.ph_lo, hi = args.ph_hi;
    XcdBarrier bar; bar.bar = (unsigned*)(F.ctl + CW_BAR); bar.x = 0; bar.st = nullptr;
    if (hi - lo > 1) bar = xcd_barrier_post((unsigned*)(F.ctl + CW_BAR), F.MISC + 8);
    bf16* XN = (bf16*)(ws + WS_XN); float* H = (float*)(ws + WS_H); float* Y = (float*)(ws + WS_Y); unsigned char* ar = ws + WS_AR;
    const float* nw = F.in[2];

    if (IN(0)) { p0_prologue(F); } SEAM(0);

    {
        const bf16* mixA;
        {
            mixA = (const bf16*)(ar + AR_MIX);
            if (IN(1)) {
                pg8::Gemm g{XN, (const bf16*)(ws + WS_WIN_E), MP, EVEN_IN, DM, DM, DM, -1}; pg8::StaticOrder S; S.init(MP, EVEN_IN, F.G, (int)blockIdx.x);
                pg8::EpiInEven E{(float*)(ar + AR_QA), (float*)(ar + AR_GL), (float*)(ar + AR_GT), (bf16*)(ar + AR_VA), (bf16*)(ar + AR_QB), (bf16*)(ar + AR_KB), (bf16*)(ar + AR_VB), F.in[4]};
                pg8::gemm_phase<pg8::EpiInEven, pg8::StaticOrder, true, true>(F.lds + RING_OFF, g, S, E);
            } SEAM(1);
            if (IN(2)) {
                attn_phase(F, (const bf16*)(ar + AR_QB), (const bf16*)(ar + AR_KB), (const bf16*)(ar + AR_VB), F.in[6], (bf16*)(ar + AR_MIX));
                hgrn_h1(F, (const float*)(ar + AR_GL), (const bf16*)(ar + AR_VA), (float*)(ar + AR_US), (float*)(ar + AR_DS));
            } SEAM(2);
            if (IN(3)) { hgrn_h2(F, (float*)(ar + AR_US), (const float*)(ar + AR_DS)); } SEAM(3);
            if (IN(4)) { hgrn_h3(F, (const float*)(ar + AR_QA), (const float*)(ar + AR_GL), (const float*)(ar + AR_GT), (const bf16*)(ar + AR_VA), (const float*)(ar + AR_US), F.in[5], (bf16*)(ar + AR_MIX)); } SEAM(4);
        }
        layer_tail<0>(F, bar, lo, hi, mixA);
        {
            mixA = (const bf16*)(ar + AR_LO);
            if (IN(11)) {
                pg8::Gemm g{XN, (const bf16*)(ws + WS_WIN_O), MP, 8192, DM, DM, DM, -1}; pg8::StaticOrder S; S.init(MP, 8192, F.G, (int)blockIdx.x);
                pg8::EpiInOdd E{(bf16*)(ar + AR_YBR), (float*)(ar + AR_XBR)};
                pg8::gemm_phase<pg8::EpiInOdd, pg8::StaticOrder, true, true>(F.lds + RING_OFF, g, S, E);
            } SEAM(11);
            if (IN(12)) { lru_conv_pass(F, (const float*)(ar + AR_XBR), F.in[9], F.in[10], (float*)(ar + AR_XC), (bf16*)(ar + AR_XCB)); } SEAM(12);
            if (IN(13)) {
                pg8::Gemm g{(const bf16*)(ar + AR_XCB), (const bf16*)(ws + WS_WG), MP, 8192, 256, DM, 256, 1}; pg8::StaticOrder S; S.init(MP, 8192, F.G, (int)blockIdx.x);
                pg8::EpiGates E{(const float*)(ar + AR_XC), F.in[12], F.in[14], (const float*)(ws + WS_LS8), (float*)(ar + AR_A), (float*)(ar + AR_BI)};
                pg8::gemm_phase<pg8::EpiGates, pg8::StaticOrder, true, true>(F.lds + RING_OFF, g, S, E);
            } SEAM(13);
            if (IN(14)) { lru_scan1(F, (const float*)(ar + AR_A), (const float*)(ar + AR_BI), (float*)(ar + AR_CA), (float*)(ar + AR_CB)); } SEAM(14);
            if (IN(15)) { lru_scan2(F, (const float*)(ar + AR_A), (const float*)(ar + AR_BI), (const float*)(ar + AR_CA), (const float*)(ar + AR_CB), (const bf16*)(ar + AR_YBR), (bf16*)(ar + AR_LO)); } SEAM(15);
        }
        layer_tail<1>(F, bar, lo, hi, mixA);
    }
}

#ifndef DBG_STOP
#define DBG_STOP -1
#endif
__global__ void dbg_copy_h(const float4* __restrict__ h, float4* __restrict__ o, size_t n4) { for (size_t i = (size_t)blockIdx.x * blockDim.x + threadIdx.x; i < n4; i += (size_t)gridDim.x * blockDim.x) o[i] = h[i]; }
extern "C" void kernel_launch(void* const* d_in, const int* in_sizes, int n_in, void* d_out, int out_size, void* d_ws, size_t ws_size, hipStream_t stream) {
    static int grid = 0;
    if (grid == 0) {
        if (n_in != 21 || out_size != SEQ * DM || ws_size < WS_END) { fprintf(stderr, "kernel_launch: unexpected problem (n_in %d out %d ws %zu need %zu)\n", n_in, out_size, ws_size, (size_t)WS_END); grid = -1; return; }
        int dev = 0, cus = 0, per_cu = 0;
        if (hipGetDevice(&dev) != hipSuccess || hipDeviceGetAttribute(&cus, hipDeviceAttributeMultiprocessorCount, dev) != hipSuccess) { grid = -1; return; }
        if (hipFuncSetAttribute((const void*)fwd_kernel, hipFuncAttributeMaxDynamicSharedMemorySize, LDS_BYTES) != hipSuccess) { fprintf(stderr, "kernel_launch: hipFuncSetAttribute failed\n"); grid = -1; return; }
        if (hipOccupancyMaxActiveBlocksPerMultiprocessor(&per_cu, (const void*)fwd_kernel, NWAVES * 64, LDS_BYTES) != hipSuccess || per_cu < 1) fprintf(stderr, "kernel_launch: occupancy query says %d\n", per_cu);
        (void)hipGetLastError();
        grid = cus;
    }
    if (grid < 0) return;
    (void)hipMemsetAsync((char*)d_ws + WS_CTL, 0, CTL_ZERO_BYTES, stream);
    Args a{};
    for (int i = 0; i < 21; ++i) a.in[i] = (const float*)d_in[i];
    a.out = (float*)d_out; a.ws = (unsigned char*)d_ws;
#if MK_SINGLE
    a.ph_lo = 0; a.ph_hi = N_PHASES;
    hipLaunchKernelGGL(fwd_kernel, dim3(grid), dim3(NWAVES * 64), LDS_BYTES, stream, a);
#else
    const int last = (DBG_STOP >= 0) ? DBG_STOP : N_PHASES - 1;
    for (int k = 0; k <= last; ++k) { a.ph_lo = k; a.ph_hi = k + 1; hipLaunchKernelGGL(fwd_kernel, dim3(grid), dim3(NWAVES * 64), LDS_BYTES, stream, a); }
    if (DBG_STOP >= 0) hipLaunchKernelGGL(dbg_copy_h, dim3(2048), dim3(256), 0, stream, (const float4*)((const char*)d_ws + WS_H), (float4*)d_out, (size_t)SEQ * DM / 4);
#endif
}
```

```cpp
#include <hip/hip_runtime.h>
#include <cstdio>
#include <cstdint>

#define GAS __attribute__((address_space(1)))
#define LAS __attribute__((address_space(3)))
typedef unsigned short bf16;
typedef unsigned v4u __attribute__((ext_vector_type(4)));
typedef unsigned v2u __attribute__((ext_vector_type(2)));
typedef float f32x4 __attribute__((ext_vector_type(4)));
typedef float f32x2 __attribute__((ext_vector_type(2)));
typedef short bf16x8 __attribute__((ext_vector_type(8)));
typedef short bf16x4 __attribute__((ext_vector_type(4)));
typedef GAS unsigned gu32;

constexpr int DM = 4096, SEQ = 8192, NMETA = 16, LTOK = SEQ + NMETA;
constexpr int MP = 8448;
constexpr int NPAN = MP / 256;
constexpr int A_HEADS = 16, A_K = 128, A_V = 128, A_F = 2048;
constexpr int B_HD = 64, B_QH = 32, B_KVH = 4, B_GRP = 8, B_W = 2048, B_KVW = 256;
constexpr int EVEN_IN = 10752, DFF = 11008, LRU_W = 4096;
constexpr int NCHUNK = 129;
constexpr float NORM_EPS = 1e-6f;

constexpr size_t MiB = 1u << 20;
constexpr size_t WS_CTL = 0, CTL_ZERO_BYTES = 1 * MiB;
constexpr size_t SZ_WIN_E = (size_t)EVEN_IN * DM * 2, SZ_W44 = (size_t)DM * DM * 2, SZ_WIN_O = (size_t)8192 * DM * 2, SZ_WG = (size_t)8192 * 256 * 2,
                 SZ_WGU = (size_t)2 * DFF * DM * 2, SZ_WD = (size_t)DM * DFF * 2;
constexpr size_t WS_WIN_E = 1 * MiB;
constexpr size_t WS_WOUT_E = WS_WIN_E + SZ_WIN_E;
constexpr size_t WS_WIN_O = WS_WOUT_E + SZ_W44;
constexpr size_t WS_WG = WS_WIN_O + SZ_WIN_O;
constexpr size_t WS_WOUT_O = WS_WG + SZ_WG;
constexpr size_t WS_WGU = WS_WOUT_O + SZ_W44;
constexpr size_t WS_WD = WS_WGU + 2 * SZ_WGU;
constexpr size_t WS_H = WS_WD + 2 * SZ_WD;
constexpr size_t SZ_F32ROW = (size_t)MP * DM * 4, SZ_BFROW = (size_t)MP * DM * 2;
constexpr size_t WS_XN = WS_H + SZ_F32ROW;
constexpr size_t WS_Y = WS_XN + SZ_BFROW;
constexpr size_t WS_AR = WS_Y + SZ_F32ROW;
constexpr size_t AR_QA = 0;
constexpr size_t AR_GL = AR_QA + (size_t)MP * 2048 * 4;
constexpr size_t AR_GT = AR_GL + (size_t)MP * 2048 * 4;
constexpr size_t AR_VA = AR_GT + (size_t)MP * 2048 * 4;
constexpr size_t AR_QB = AR_VA + (size_t)MP * 2048 * 2;
constexpr size_t AR_KB = AR_QB + (size_t)MP * 2048 * 2;
constexpr size_t AR_VB = AR_KB + (size_t)MP * 256 * 2;
constexpr size_t AR_US = AR_VB + (size_t)MP * 256 * 2;
constexpr size_t AR_DS = AR_US + (size_t)A_HEADS * NCHUNK * 16384 * 4;
constexpr size_t AR_MIX = AR_DS + (size_t)A_HEADS * NCHUNK * 128 * 4;
constexpr size_t AR_L0_END = AR_MIX + SZ_BFROW;
constexpr size_t AR_G = 0;
constexpr size_t AR_U = AR_G + (size_t)MP * DFF * 4;
constexpr size_t AR_ACT = AR_U + (size_t)MP * DFF * 2;
constexpr size_t AR_FFN_END = AR_ACT + (size_t)MP * DFF * 2;
constexpr size_t AR_YBR = 0;
constexpr size_t AR_XBR = AR_YBR + SZ_BFROW;
constexpr size_t AR_XC = AR_XBR + SZ_F32ROW;
constexpr size_t AR_XCB = AR_XC + SZ_F32ROW;
constexpr size_t AR_A = AR_XCB + SZ_BFROW;
constexpr size_t AR_BI = AR_A + SZ_F32ROW;
constexpr size_t AR_CA = AR_BI + SZ_F32ROW;
constexpr size_t AR_CB = AR_CA + (size_t)NCHUNK * DM * 4;
constexpr size_t AR_LO = AR_CB + (size_t)NCHUNK * DM * 4;
constexpr size_t AR_L1_END = AR_LO + SZ_BFROW;
constexpr size_t AR_SIZE = (AR_FFN_END > AR_L0_END ? (AR_FFN_END > AR_L1_END ? AR_FFN_END : AR_L1_END) : (AR_L0_END > AR_L1_END ? AR_L0_END : AR_L1_END));
constexpr size_t WS_END = WS_AR + AR_SIZE;

constexpr size_t WS_LS8 = 512 * 1024;
constexpr int CW_TMO = 0, CW_CODE = 1;
constexpr int CW_BAR = 4096;

constexpr int RING_OFF = 0, RING_BYTES = 131072;
constexpr int LDSCTL_OFF = RING_BYTES, MISC_OFF = LDSCTL_OFF + 320;
constexpr int LDS_BYTES = 147456;
constexpr int NWAVES = 8;

#define RLX_AGENT __ATOMIC_RELAXED, __HIP_MEMORY_SCOPE_AGENT
#define LDS_WAIT() asm volatile("s_waitcnt lgkmcnt(0)" ::: "memory")
#define VM_WAIT() asm volatile("s_waitcnt vmcnt(0)" ::: "memory")
__device__ __forceinline__ unsigned f2bf(float f) { unsigned u = __builtin_bit_cast(unsigned, f); return (u + 0x7fffu + ((u >> 16) & 1u)) >> 16; }
__device__ __forceinline__ unsigned pk2(float lo, float hi) { return f2bf(lo) | (f2bf(hi) << 16); }
__device__ __forceinline__ float bflo(unsigned w) { return __builtin_bit_cast(float, w << 16); }
__device__ __forceinline__ float bfhi(unsigned w) { return __builtin_bit_cast(float, w & 0xffff0000u); }
__device__ __forceinline__ float bf1(bf16 h) { return __builtin_bit_cast(float, ((unsigned)h) << 16); }
__device__ __forceinline__ float fexp(float x) { return __builtin_amdgcn_exp2f(x * 1.4426950408889634f); }
__device__ __forceinline__ float frcp(float x) { return __builtin_amdgcn_rcpf(x); }
__device__ __forceinline__ float fsigmoid(float x) { return frcp(1.0f + fexp(-x)); }
__device__ __forceinline__ float fsilu(float x) { return x * fsigmoid(x); }
__device__ __forceinline__ float fgelu_tanh(float x) { const float t = 0.7978845608028654f * (x + 0.044715f * x * x * x); return x * frcp(1.0f + fexp(-2.0f * t)); }
__device__ __forceinline__ float wave_sum(float v) {
#pragma unroll
    for (int o = 1; o < 64; o <<= 1) v += __shfl_xor(v, o);
    return v;
}
namespace pg8 {
#define PG8_LAS __attribute__((address_space(3)))
typedef unsigned short bf16_t;
typedef short bf16x8 __attribute__((ext_vector_type(8)));
typedef float f32x4 __attribute__((ext_vector_type(4)));
typedef unsigned u32x4 __attribute__((ext_vector_type(4)));
constexpr int BM = 256, BK = 64, HALF = 128, HTB = HALF * BK * 2  , STAGE_BYTES = 8 * HTB, NXCD = 8, WGM = 8;

__host__ __device__ __forceinline__ int lds_byte(int r, int c) { const int st = (r >> 4) * 2 + (c >> 5), rr = r & 15, cc = c & 31, ob = rr * 64 + cc * 2; return st * 1024 + (ob ^ (((ob >> 9) & 1) << 5)); }
__host__ __device__ __forceinline__ void stage_rc(int b, int& R, int& C) { const int st = b / 1024, sb = b % 1024, swz = sb ^ (((sb >> 9) & 1) << 5); R = (st >> 1) * 16 + swz / 64; C = (st & 1) * 32 + (swz % 64) / 2; }
__host__ __device__ __forceinline__ int perm32(int rho) { const int n = rho >> 4, i = rho & 15; return 8 * (i >> 2) + 4 * n + (i & 3); }

struct Unit { int pm, pn; };
struct Gemm { const bf16_t* A; const bf16_t* Bt; int M, N, K; int lda, ldb; int acol_shift; };

struct StaticOrder {
    int nM, nN, nwg, G, c;
    __host__ __device__ void init(int M, int N, int G_, int c_) { nM = M / BM; nN = N / BM; nwg = nM * nN; G = G_; c = c_; }
    __host__ __device__ bool next(int i, Unit& u) const {
        const long L = (long)i * G + c; if (L >= nwg) return false;
        int wgid = (int)L; { const int q = nwg / NXCD, r = nwg % NXCD, xcd = wgid % NXCD, off = wgid / NXCD; wgid = (xcd < r ? xcd * (q + 1) : r * (q + 1) + (xcd - r) * q) + off; }
        const int nig = WGM * nN, gid = wgid / nig, fm = gid * WGM, gsz = (nM - fm) < WGM ? (nM - fm) : WGM;
        u.pm = fm + ((wgid % nig) % gsz); u.pn = (wgid % nig) / gsz; return true;
    }
    __device__ __forceinline__ void a_ready(const Unit&) const {}
    __device__ __forceinline__ void done(const Unit&) const {}
};
__device__ __forceinline__ unsigned cvt_pk_bf16(float lo, float hi) { unsigned r; asm volatile("v_cvt_pk_bf16_f32 %0, %1, %2" : "=v"(r) : "v"(lo), "v"(hi)); return r; }
}
namespace pg8 {
__device__ __forceinline__ void st_f32x8(float* p, f32x4 a, f32x4 b) { *(f32x4*)p = a; *(f32x4*)(p + 4) = b; }
__device__ __forceinline__ void st_bf16x8(bf16_t* p, f32x4 a, f32x4 b) { u32x4 w; w.x = cvt_pk_bf16(a[0], a[1]); w.y = cvt_pk_bf16(a[2], a[3]); w.z = cvt_pk_bf16(b[0], b[1]); w.w = cvt_pk_bf16(b[2], b[3]); *(u32x4*)p = w; }

struct EpiF32 {
    static constexpr bool PERM = true, AFTER_DRAIN = false;
    float* C; int ldc;
    __device__ __forceinline__ void operator()(const f32x4 (&acc)[2][2][4][2], const Unit& u, int wr, int wc, int fr, int fq) const {
        const unsigned lo = (unsigned)((wr * 64 + fr) * ldc + wc * 32 + 8 * fq);
#pragma unroll
        for (int ai = 0; ai < 2; ++ai)
#pragma unroll
            for (int m = 0; m < 4; ++m) { float* rowp = C + (size_t)(u.pm * BM + ai * HALF + m * 16) * ldc + u.pn * BM;
#pragma unroll
                for (int bj = 0; bj < 2; ++bj) st_f32x8(rowp + lo + bj * HALF, acc[ai][bj][m][0], acc[ai][bj][m][1]); }
    }
};

struct EpiInEven {
    static constexpr bool PERM = true, AFTER_DRAIN = false;
    float* QA; float* GL; float* GT; bf16_t* VA; bf16_t* QB; bf16_t* KB; bf16_t* VB; const float* lbl;
    __device__ __forceinline__ void operator()(const f32x4 (&acc)[2][2][4][2], const Unit& u, int wr, int wc, int fr, int fq) const {
        const int seg = u.pn >> 3; const int cu = (u.pn & 7) * BM;
        const unsigned lc = (unsigned)(wc * 32 + 8 * fq);
        const unsigned lo = (unsigned)((wr * 64 + fr) * 2048) + lc;
        if (seg == 0 || seg == 3) {
            float* D = (seg == 0 ? QA : GT) + (size_t)(u.pm * BM) * 2048 + cu;
#pragma unroll
            for (int ai = 0; ai < 2; ++ai)
#pragma unroll
                for (int m = 0; m < 4; ++m) { float* rowp = D + (size_t)(ai * HALF + m * 16) * 2048;
#pragma unroll
                    for (int bj = 0; bj < 2; ++bj) { f32x4 a = acc[ai][bj][m][0], b = acc[ai][bj][m][1];
#pragma unroll
                        for (int j = 0; j < 4; ++j) { a[j] = fsilu(a[j]); b[j] = fsilu(b[j]); }
                        st_f32x8(rowp + lo + bj * HALF, a, b); } }
        } else if (seg == 1) {
            f32x4 lb[2][2];
#pragma unroll
            for (int bj = 0; bj < 2; ++bj)
#pragma unroll
                for (int n = 0; n < 2; ++n) { const f32x4 l0 = *(const f32x4*)(lbl + cu + lc + bj * HALF + 4 * n), l1 = *(const f32x4*)(lbl + 2048 + cu + lc + bj * HALF + 4 * n);
#pragma unroll
                    for (int j = 0; j < 4; ++j) lb[bj][n][j] = frcp(1.0f + fexp(l1[j] - l0[j])); }
            float* D = GL + (size_t)(u.pm * BM) * 2048 + cu;
#pragma unroll
            for (int ai = 0; ai < 2; ++ai)
#pragma unroll
                for (int m = 0; m < 4; ++m) { float* rowp = D + (size_t)(ai * HALF + m * 16) * 2048;
#pragma unroll
                    for (int bj = 0; bj < 2; ++bj) { f32x4 a = acc[ai][bj][m][0], b = acc[ai][bj][m][1];
#pragma unroll
                        for (int j = 0; j < 4; ++j) { a[j] = __logf(lb[bj][0][j] + (1.0f - lb[bj][0][j]) * fsigmoid(a[j])); b[j] = __logf(lb[bj][1][j] + (1.0f - lb[bj][1][j]) * fsigmoid(b[j])); }
                        st_f32x8(rowp + lo + bj * HALF, a, b); } }
        } else if (seg == 2 || seg == 4) {
            bf16_t* D = (seg == 2 ? VA : QB) + (size_t)(u.pm * BM) * 2048 + cu;
#pragma unroll
            for (int ai = 0; ai < 2; ++ai)
#pragma unroll
                for (int m = 0; m < 4; ++m) { bf16_t* rowp = D + (size_t)(ai * HALF + m * 16) * 2048;
#pragma unroll
                    for (int bj = 0; bj < 2; ++bj) st_bf16x8(rowp + lo + bj * HALF, acc[ai][bj][m][0], acc[ai][bj][m][1]); }
        } else {
            bf16_t* D = ((u.pn == 40) ? KB : VB) + (size_t)(u.pm * BM) * 256; const unsigned lo2 = (unsigned)((wr * 64 + fr) * 256) + lc;
#pragma unroll
            for (int ai = 0; ai < 2; ++ai)
#pragma unroll
                for (int m = 0; m < 4; ++m) { bf16_t* rowp = D + (size_t)(ai * HALF + m * 16) * 256;
#pragma unroll
                    for (int bj = 0; bj < 2; ++bj) st_bf16x8(rowp + lo2 + bj * HALF, acc[ai][bj][m][0], acc[ai][bj][m][1]); }
        }
    }
};

struct EpiGU {
    static constexpr bool PERM = true, AFTER_DRAIN = false;
    float* G; bf16_t* U;
    __device__ __forceinline__ void operator()(const f32x4 (&acc)[2][2][4][2], const Unit& u, int wr, int wc, int fr, int fq) const {
        const unsigned lo = (unsigned)((wr * 64 + fr) * DFF + wc * 32 + 8 * fq);
#pragma unroll
        for (int ai = 0; ai < 2; ++ai)
#pragma unroll
            for (int m = 0; m < 4; ++m) { const size_t ro = (size_t)(u.pm * BM + ai * HALF + m * 16) * DFF + u.pn * HALF;
                st_f32x8(G + ro + lo, acc[ai][0][m][0], acc[ai][0][m][1]); st_bf16x8(U + ro + lo, acc[ai][1][m][0], acc[ai][1][m][1]); }
    }
};

struct EpiInOdd {
    static constexpr bool PERM = true, AFTER_DRAIN = false;
    bf16_t* Y; float* X;
    __device__ __forceinline__ void operator()(const f32x4 (&acc)[2][2][4][2], const Unit& u, int wr, int wc, int fr, int fq) const {
        const unsigned lo = (unsigned)((wr * 64 + fr) * DM + wc * 32 + 8 * fq);
        if (u.pn < 16) {
#pragma unroll
            for (int ai = 0; ai < 2; ++ai)
#pragma unroll
                for (int m = 0; m < 4; ++m) { bf16_t* rowp = Y + (size_t)(u.pm * BM + ai * HALF + m * 16) * DM + (u.pn & 15) * BM;
#pragma unroll
                    for (int bj = 0; bj < 2; ++bj) { f32x4 a = acc[ai][bj][m][0], b = acc[ai][bj][m][1];
#pragma unroll
                        for (int j = 0; j < 4; ++j) { a[j] = fgelu_tanh(a[j]); b[j] = fgelu_tanh(b[j]); }
                        st_bf16x8(rowp + lo + bj * HALF, a, b); } }
        } else {
#pragma unroll
            for (int ai = 0; ai < 2; ++ai)
#pragma unroll
                for (int m = 0; m < 4; ++m) { float* rowp = X + (size_t)(u.pm * BM + ai * HALF + m * 16) * DM + (u.pn & 15) * BM;
#pragma unroll
                    for (int bj = 0; bj < 2; ++bj) st_f32x8(rowp + lo + bj * HALF, acc[ai][bj][m][0], acc[ai][bj][m][1]); }
        }
    }
};

struct EpiGates {
    static constexpr bool PERM = true, AFTER_DRAIN = false;
    const float* XC; const float* ba; const float* bx; const float* ls8; float* A; float* BI;
    __device__ __forceinline__ void operator()(const f32x4 (&acc)[2][2][4][2], const Unit& u, int wr, int wc, int fr, int fq) const {
        const int chu = (u.pn >> 1) * BM + (u.pn & 1) * HALF; const unsigned lc = (unsigned)(wc * 32 + 8 * fq), lo = (unsigned)((wr * 64 + fr) * DM) + lc;
        f32x4 vba[2], vbx[2], vls[2];
#pragma unroll
        for (int n = 0; n < 2; ++n) { vba[n] = *(const f32x4*)(ba + chu + lc + 4 * n); vbx[n] = *(const f32x4*)(bx + chu + lc + 4 * n); vls[n] = *(const f32x4*)(ls8 + chu + lc + 4 * n); }
#pragma unroll
        for (int ai = 0; ai < 2; ++ai)
#pragma unroll
            for (int m = 0; m < 4; ++m) { const size_t ro = (size_t)(u.pm * BM + ai * HALF + m * 16) * DM + chu;
#pragma unroll
                for (int n = 0; n < 2; ++n) {
                    const f32x4 x = *(const f32x4*)(XC + ro + lo + 4 * n); f32x4 a, b;
#pragma unroll
                    for (int j = 0; j < 4; ++j) { const float la = vls[n][j] * fsigmoid(acc[ai][0][m][n][j] + vba[n][j]); const float t = 2.0f * la;
                        const float ser = t * (1.0f + 0.5f * t * (1.0f + (1.0f / 3.0f) * t * (1.0f + 0.25f * t * (1.0f + 0.2f * t * (1.0f + (1.0f / 6.0f) * t)))));
                        const float em1 = t > -0.25f ? ser : fexp(t) - 1.0f;
                        a[j] = fexp(la); b[j] = __builtin_sqrtf(-em1) * (fsigmoid(acc[ai][1][m][n][j] + vbx[n][j]) * x[j]); }
                    *(f32x4*)(A + ro + lo + 4 * n) = a; *(f32x4*)(BI + ro + lo + 4 * n) = b; }
                asm volatile("" ::: "memory"); }
    }
};
}
namespace pg8 {
template <class Epi, class Sched, bool ALIGN_EPI = false, bool SP2 = false>
__device__ __forceinline__ void gemm_phase(PG8_LAS unsigned char* lds, const Gemm g, const Sched& S, const Epi& E) {
    const int tid = threadIdx.x, wid = __builtin_amdgcn_readfirstlane(tid >> 6), lane = tid & 63, wr = wid >> 2, wc = wid & 3, fr = lane & 15, fq = lane >> 4;
    const int K = g.K, nt = K / BK;
    unsigned voffA[2], voffB[2];
#pragma unroll
    for (int i = 0; i < 2; ++i) { int R, C; stage_rc(tid * 16 + i * 8192, R, C); const int Rb = Epi::PERM ? ((R & ~31) + perm32(R & 31)) : R;
        voffA[i] = (unsigned)(R * g.lda + C) * 2u; voffB[i] = (unsigned)(Rb * g.ldb + C) * 2u; }
    const size_t kstep = (size_t)(BK * 2);
    const size_t hstepA = (size_t)HALF * g.lda * 2, hstepB = (size_t)HALF * g.ldb * 2;
    const size_t tstepA = 2 * hstepA, tstepB = 2 * hstepB;
#define PG8_ABASE(u) ((const char*)g.A + (size_t)(u).pm * tstepA + (g.acol_shift >= 0 ? (size_t)(((u).pn >> g.acol_shift) * 512) : (size_t)0))
    const unsigned ldsw = (unsigned)wid * 1024u;
    const int aoff = lds_byte(wr * 64 + fr, fq * 8), boff = lds_byte(wc * 32 + fr, fq * 8);
#define PG8_SA(b, h) (((b) * 2 + (h)) * HTB)
#define PG8_SB(b, h) ((4 + (b) * 2 + (h)) * HTB)
#define PG8_STAGE(bufoff, gbase, voff) do { _Pragma("unroll") for (int _i = 0; _i < 2; ++_i) \
        __builtin_amdgcn_global_load_lds((const unsigned*)((const char*)(gbase) + (voff)[_i]), (PG8_LAS unsigned*)(lds + (bufoff) + ldsw + _i * 8192), 16, 0, 0); } while (0)
#define PG8_LDA(dst, b, h) do { _Pragma("unroll") for (int m = 0; m < 4; ++m) _Pragma("unroll") for (int k = 0; k < 2; ++k) dst[m][k] = *(const PG8_LAS bf16x8*)(lds + PG8_SA(b, h) + aoff + m * 2048 + k * 1024); } while (0)
#define PG8_LDB(dst, b, h) do { _Pragma("unroll") for (int n = 0; n < 2; ++n) _Pragma("unroll") for (int k = 0; k < 2; ++k) dst[n][k] = *(const PG8_LAS bf16x8*)(lds + PG8_SB(b, h) + boff + n * 2048 + k * 1024); } while (0)
#define PG8_MMA(ai, bj, At, Bt) do { __builtin_amdgcn_s_setprio(1); _Pragma("unroll") for (int m = 0; m < 4; ++m) _Pragma("unroll") for (int n = 0; n < 2; ++n) _Pragma("unroll") for (int k = 0; k < 2; ++k) \
        acc[ai][bj][m][n] = __builtin_amdgcn_mfma_f32_16x16x32_bf16(Bt[n][k], At[m][k], acc[ai][bj][m][n], 0, 0, 0); __builtin_amdgcn_s_setprio(0); } while (0)
#define PG8_WAIT_V(n) asm volatile("s_waitcnt vmcnt(" #n ")" ::: "memory")
#define PG8_WAIT_L(n) asm volatile("s_waitcnt lgkmcnt(" #n ")" ::: "memory")
#define PG8_BAR __builtin_amdgcn_s_barrier()
#define PG8_SCHED __builtin_amdgcn_sched_barrier(0)
    Unit cur, nxt; int ui = 0;
    if (!S.next(0, cur)) return;
    f32x4 acc[2][2][4][2];
#pragma unroll
    for (int a = 0; a < 2; ++a)
#pragma unroll
        for (int b = 0; b < 2; ++b)
#pragma unroll
            for (int m = 0; m < 4; ++m)
#pragma unroll
                for (int n = 0; n < 2; ++n) acc[a][b][m][n] = (f32x4){0.f, 0.f, 0.f, 0.f};
    bf16x8 At[4][2], B0[2][2], B1[2][2];
    const char* cA = PG8_ABASE(cur); const char* cB = (const char*)g.Bt + (size_t)cur.pn * tstepB;
    S.a_ready(cur);
    if constexpr (SP2) {
        PG8_STAGE(PG8_SB(0, 0), cB, voffB); PG8_STAGE(PG8_SB(0, 1), cB + hstepB, voffB); PG8_STAGE(PG8_SA(0, 0), cA, voffA); PG8_STAGE(PG8_SA(0, 1), cA + hstepA, voffA);
        if (wr == 1) PG8_BAR;
        PG8_WAIT_V(2); PG8_BAR;
        PG8_STAGE(PG8_SB(1, 0), cB + kstep, voffB); PG8_STAGE(PG8_SA(1, 0), cA + kstep, voffA); PG8_STAGE(PG8_SB(1, 1), cB + hstepB + kstep, voffB);
        PG8_WAIT_V(6); PG8_BAR;
    } else {
        PG8_STAGE(PG8_SB(0, 0), cB, voffB); PG8_STAGE(PG8_SA(0, 0), cA, voffA); PG8_STAGE(PG8_SB(0, 1), cB + hstepB, voffB); PG8_STAGE(PG8_SA(0, 1), cA + hstepA, voffA);
        if (wr == 1) PG8_BAR;
        PG8_WAIT_V(4); PG8_BAR;
        PG8_STAGE(PG8_SB(1, 0), cB + kstep, voffB); PG8_STAGE(PG8_SA(1, 0), cA + kstep, voffA); PG8_STAGE(PG8_SB(1, 1), cB + hstepB + kstep, voffB);
        PG8_WAIT_V(6); PG8_BAR;
    }
    for (;;) {
        const bool has_next = S.next(ui + 1, nxt);
        const char* nA = has_next ? PG8_ABASE(nxt) : cA; const char* nB = has_next ? (const char*)g.Bt + (size_t)nxt.pn * tstepB : cB;
#pragma nounroll
        for (int t = 0; t < nt; t += 2) {
            const bool last = (t == nt - 2);
            const char* a1 = cA + (size_t)(t + 1) * kstep;
            const char* a2 = last ? nA : cA + (size_t)(t + 2) * kstep; const char* b2 = last ? nB : cB + (size_t)(t + 2) * kstep;
            const char* a3 = a2 + kstep; const char* b3 = b2 + kstep;
            if (last && has_next) S.a_ready(nxt);
            if constexpr (SP2) {
            PG8_LDB(B0, 0, 0); PG8_LDB(B1, 0, 1); PG8_SCHED; PG8_LDA(At, 0, 0); PG8_STAGE(PG8_SA(1, 1), a1 + hstepA, voffA);
            PG8_WAIT_V(8); PG8_WAIT_L(0); PG8_BAR; PG8_MMA(0, 0, At, B0); PG8_MMA(0, 1, At, B1); PG8_BAR; PG8_SCHED;
            PG8_LDA(At, 0, 1); PG8_STAGE(PG8_SB(0, 0), b2, voffB); PG8_STAGE(PG8_SB(0, 1), b2 + hstepB, voffB); PG8_STAGE(PG8_SA(0, 0), a2, voffA);
            PG8_WAIT_V(8); PG8_WAIT_L(0); PG8_BAR; PG8_MMA(1, 0, At, B0); PG8_MMA(1, 1, At, B1); PG8_BAR; PG8_SCHED;
            PG8_LDB(B0, 1, 0); PG8_LDB(B1, 1, 1); PG8_SCHED; PG8_LDA(At, 1, 0); PG8_STAGE(PG8_SA(0, 1), a2 + hstepA, voffA);
            PG8_WAIT_V(8); PG8_WAIT_L(0); PG8_BAR; PG8_MMA(0, 0, At, B0); PG8_MMA(0, 1, At, B1); PG8_BAR; PG8_SCHED;
            PG8_LDA(At, 1, 1); PG8_STAGE(PG8_SB(1, 0), b3, voffB); PG8_STAGE(PG8_SB(1, 1), b3 + hstepB, voffB); PG8_STAGE(PG8_SA(1, 0), a3, voffA);
            PG8_WAIT_V(8); PG8_WAIT_L(0); PG8_BAR; PG8_MMA(1, 0, At, B0); PG8_MMA(1, 1, At, B1); PG8_BAR; PG8_SCHED;
            } else {
            PG8_LDB(B0, 0, 0); PG8_SCHED; PG8_LDA(At, 0, 0); PG8_STAGE(PG8_SA(1, 1), a1 + hstepA, voffA);
            PG8_WAIT_L(8); PG8_BAR; PG8_WAIT_L(0); PG8_MMA(0, 0, At, B0); PG8_BAR; PG8_SCHED;
            PG8_LDB(B1, 0, 1); PG8_STAGE(PG8_SB(0, 0), b2, voffB);
            PG8_BAR; PG8_WAIT_L(0); PG8_MMA(0, 1, At, B1); PG8_BAR;
            PG8_LDA(At, 0, 1); PG8_STAGE(PG8_SA(0, 0), a2, voffA);
            PG8_BAR; PG8_WAIT_L(0); PG8_MMA(1, 0, At, B0); PG8_BAR; PG8_SCHED;
            PG8_STAGE(PG8_SB(0, 1), b2 + hstepB, voffB);
            PG8_WAIT_V(6); PG8_BAR; PG8_MMA(1, 1, At, B1); PG8_BAR;
            PG8_LDB(B0, 1, 0); PG8_SCHED; PG8_LDA(At, 1, 0); PG8_STAGE(PG8_SA(0, 1), a2 + hstepA, voffA);
            PG8_WAIT_L(8); PG8_BAR; PG8_WAIT_L(0); PG8_MMA(0, 0, At, B0); PG8_BAR; PG8_SCHED;
            PG8_LDB(B1, 1, 1); PG8_STAGE(PG8_SB(1, 0), b3, voffB);
            PG8_BAR; PG8_WAIT_L(0); PG8_MMA(0, 1, At, B1); PG8_BAR;
            PG8_LDA(At, 1, 1); PG8_STAGE(PG8_SA(1, 0), a3, voffA);
            PG8_BAR; PG8_WAIT_L(0); PG8_MMA(1, 0, At, B0); PG8_BAR; PG8_SCHED;
            PG8_STAGE(PG8_SB(1, 1), b3 + hstepB, voffB);
            PG8_WAIT_V(6); PG8_BAR; PG8_MMA(1, 1, At, B1); PG8_BAR;
            }
        }
        if constexpr (ALIGN_EPI) { if (wr == 0) PG8_BAR; }
        if constexpr (!Epi::AFTER_DRAIN) { E(acc, cur, wr, wc, fr, fq); S.done(cur); }
        if (!has_next) break;
#pragma unroll
        for (int a = 0; a < 2; ++a)
#pragma unroll
            for (int b = 0; b < 2; ++b)
#pragma unroll
                for (int m = 0; m < 4; ++m)
#pragma unroll
                    for (int n = 0; n < 2; ++n) acc[a][b][m][n] = (f32x4){0.f, 0.f, 0.f, 0.f};
        cur = nxt; cA = nA; cB = nB; ++ui;
        if constexpr (ALIGN_EPI) { if (wr == 1) PG8_BAR; }
    }
    PG8_WAIT_V(0);
    if constexpr (!ALIGN_EPI) { if (wr == 0) PG8_BAR; }
    PG8_BAR;
    if constexpr (Epi::AFTER_DRAIN) { E.fused(acc, cur, wr, wc, fr, fq, lds, wid, lane); S.done(cur); }
#undef PG8_ABASE
#undef PG8_SA
#undef PG8_SB
#undef PG8_STAGE
#undef PG8_LDA
#undef PG8_LDB
#undef PG8_MMA
#undef PG8_WAIT_V
#undef PG8_WAIT_L
#undef PG8_BAR
#undef PG8_SCHED
}
}
#define XB_TMO      128
#define XB_XCNT(j)  (256  + 64 * (j))
#define XB_XSUB(j)  (1280 + 64 * (j))
#define XB_XGEN(j)  (2304 + 64 * (j))
#define XB_TOP      3328
#define XB_TOPGEN   3392
#define XCD_BAR_WORDS 3456
#define XB_SPIN_CAP (1u << 18)

__device__ __forceinline__ unsigned xb_ld(unsigned* p)              { return __hip_atomic_load(p, __ATOMIC_RELAXED, __HIP_MEMORY_SCOPE_AGENT); }
__device__ __forceinline__ unsigned xb_add(unsigned* p, unsigned v) { return __hip_atomic_fetch_add(p, v, __ATOMIC_RELAXED, __HIP_MEMORY_SCOPE_AGENT); }
__device__ __forceinline__ unsigned xb_xcc_id() { return (unsigned)__builtin_amdgcn_s_getreg((3 << 11) | 20) & 0xFu; }
#define XB_SPIN(cond, bar) do { unsigned _sp = 0; while (cond) { __builtin_amdgcn_s_sleep(1); \
    if ((++_sp & 255u) == 0u) { if (xb_ld(&(bar)[XB_TMO])) break; if (_sp > XB_SPIN_CAP) { atomicAdd(&(bar)[XB_TMO], 1u); break; } } } } while (0)

struct XcdBarrier {
    unsigned* bar; unsigned x;
    volatile LAS unsigned* st;
};

__device__ __forceinline__ XcdBarrier xcd_barrier_post(unsigned* bar, volatile LAS unsigned* st) {
    XcdBarrier b; b.bar = bar; b.x = xb_xcc_id(); b.st = st;
    if (threadIdx.x == 0) (void)xb_add(&bar[XB_XCNT(b.x)], 1u);
    return b;
}
__device__ __forceinline__ void xcd_barrier_complete(unsigned* bar, unsigned x, unsigned& nloc, unsigned& nx) {
    const unsigned G = gridDim.x * gridDim.y * gridDim.z;
    unsigned sum, cnt, mine, sp = 0u;
    for (;;) {
        sum = 0u; cnt = 0u; mine = 0u;
#pragma unroll
        for (unsigned j = 0; j < 16; ++j) { const unsigned c = xb_ld(&bar[XB_XCNT(j)]); sum += c; cnt += (c > 0u) ? 1u : 0u; mine = (j == x) ? c : mine; }
        if (sum == G) break;
        __builtin_amdgcn_s_sleep(1);
        if ((++sp & 255u) == 0u) { if (xb_ld(&bar[XB_TMO])) break; if (sp > XB_SPIN_CAP) { atomicAdd(&bar[XB_TMO], 1u); break; } }
    }
    nloc = mine > 0u ? mine : 1u; nx = cnt > 0u ? cnt : 1u;
}

__device__ __forceinline__ void xcd_barrier(const XcdBarrier& b) {
    asm volatile("s_waitcnt vmcnt(0)" ::: "memory");
    __syncthreads();
    if (threadIdx.x == 0) {
        unsigned* bar = b.bar;
        __builtin_amdgcn_s_waitcnt(0);
        unsigned nloc = b.st[0], nx = b.st[1];
        if (nloc == 0u) { xcd_barrier_complete(bar, b.x, nloc, nx); b.st[0] = nloc; b.st[1] = nx; }
        const unsigned old = xb_add(&bar[XB_XSUB(b.x)], 1u);
        const unsigned gen = old / nloc;
        if (old + 1u == (gen + 1u) * nloc) {
            __builtin_amdgcn_fence(__ATOMIC_RELEASE, "agent");
            asm volatile("s_waitcnt vmcnt(0)" ::: "memory");
            const unsigned og = xb_add(&bar[XB_TOP], 1u);
            const unsigned tg = og / nx;
            if (og + 1u == (tg + 1u) * nx) xb_add(&bar[XB_TOPGEN], 1u);
            else XB_SPIN(xb_ld(&bar[XB_TOPGEN]) == tg, bar);
            __builtin_amdgcn_fence(__ATOMIC_ACQUIRE, "agent");
            xb_add(&bar[XB_XGEN(b.x)], 1u);
            asm volatile("s_waitcnt vmcnt(0)" ::: "memory");
        } else {
            XB_SPIN(xb_ld(&bar[XB_XGEN(b.x)]) == gen, bar);
            __builtin_amdgcn_fence(__ATOMIC_ACQUIRE, "agent");
            asm volatile("s_waitcnt vmcnt(0)" ::: "memory");
        }
    }
    __syncthreads();
}
struct Frame {
    LAS unsigned char* lds;
    volatile LAS unsigned* MISC;
    gu32* ctl;
    int tid, lane, wave;
    int vcu, G;
    unsigned char* ws;
    const float* in[21];
    float* out;
};
__device__ __forceinline__ int prev_row(int r) { return r == SEQ ? -1 : (r == 0 ? LTOK - 1 : r - 1); }
__device__ __forceinline__ const float* base_row(const Frame& F, int r) { return r < SEQ ? F.in[0] + (size_t)r * DM : F.in[1] + (size_t)(r - SEQ) * DM; }

__device__ __forceinline__ void transpose_item(const float* W, int N, bf16* WT, int ldk, int k0, int n0, int drow0, LAS float* scr, int lane) {
#pragma unroll 8
    for (int i = 0; i < 32; ++i) { const int kk = 2 * i + (lane >> 5); scr[kk * 33 + (lane & 31)] = W[(size_t)(k0 + kk) * N + n0 + (lane & 31)]; }
    LDS_WAIT(); asm volatile("" ::: "memory");
    const int c = lane & 7;
#pragma unroll
    for (int j = 0; j < 4; ++j) { const int n = (lane >> 3) + 8 * j; const LAS float* s = scr + (8 * c) * 33 + n;
        v4u o; o.x = pk2(s[0 * 33], s[1 * 33]); o.y = pk2(s[2 * 33], s[3 * 33]); o.z = pk2(s[4 * 33], s[5 * 33]); o.w = pk2(s[6 * 33], s[7 * 33]);
        *(GAS v4u*)(WT + (size_t)(drow0 + n) * ldk + k0 + 8 * c) = o; }
    LDS_WAIT(); asm volatile("" ::: "memory");
}
__device__ __forceinline__ void tr_plain(const float* W, int K, int N, bf16* WT, int item, LAS float* scr, int lane) {
    const int nblk = N / 32, kb = item / nblk, nb = item % nblk; transpose_item(W, N, WT, K, 64 * kb, 32 * nb, 32 * nb, scr, lane);
}
__device__ __forceinline__ void tr_gu(const float* W, bf16* WT, int item, LAS float* scr, int lane) {
    const int nblk = (2 * DFF) / 32, kb = item / nblk, nb = item % nblk, n0 = 32 * nb; const int isup = n0 >= DFF, c0 = isup ? n0 - DFF : n0;
    transpose_item(W, 2 * DFF, WT, DM, 64 * kb, n0, 256 * (c0 >> 7) + (c0 & 127) + (isup ? 128 : 0), scr, lane);
}
__device__ __forceinline__ void tr_lru(const float* W, bf16* WT, int isx, int item, LAS float* scr, int lane) {
    const int h = item >> 5, r = item & 31, kb = r >> 3, nb = r & 7, j0 = 32 * nb;
    transpose_item(W + (size_t)h * 65536, 256, WT, 256, 64 * kb, j0, 256 * (2 * h + (j0 >> 7)) + (j0 & 127) + (isx ? 128 : 0), scr, lane);
}
__device__ __forceinline__ void rms_row_to_bf16(const Frame& F, const float* xrow, const float* w, bf16* orow) {
    const GAS f32x4* xr = (const GAS f32x4*)xrow + F.lane; const GAS f32x4* wr = (const GAS f32x4*)w + F.lane;
    f32x4 v[16]; float s = 0.f;
#pragma unroll
    for (int j = 0; j < 16; ++j) { v[j] = xr[64 * j]; s += (v[j].x * v[j].x + v[j].y * v[j].y) + (v[j].z * v[j].z + v[j].w * v[j].w); }
    const float rstd = 1.0f / sqrtf(wave_sum(s) * (1.f / DM) + NORM_EPS);
    GAS v2u* o8 = (GAS v2u*)orow + F.lane;
#pragma unroll
    for (int j = 0; j < 16; ++j) { const f32x4 g = wr[64 * j]; v2u o; o.x = pk2(v[j].x * rstd * g.x, v[j].y * rstd * g.y); o.y = pk2(v[j].z * rstd * g.z, v[j].w * rstd * g.w); o8[64 * j] = o; }
}
__device__ __forceinline__ void p0_prologue(Frame& F) {
    LAS float* scr = (LAS float*)(F.lds + RING_OFF + F.wave * 16384);
    const int gw = F.vcu * NWAVES + F.wave, NGW = F.G * NWAVES;
    constexpr int I_INE = (DM / 64) * (EVEN_IN / 32), I_44 = (DM / 64) * (DM / 32), I_INO = (DM / 64) * (8192 / 32), I_LRU = 16 * 32, I_GU = (DM / 64) * (2 * DFF / 32), I_D = (DFF / 64) * (DM / 32);
    constexpr int NITEMS = I_INE + I_44 + I_INO + 2 * I_LRU + I_44 + 2 * I_GU + 2 * I_D;
    unsigned char* ws = F.ws;
    for (int it = gw; it < NITEMS; it += NGW) {
        int r = it;
        if (r < I_INE) { tr_plain(F.in[3], DM, EVEN_IN, (bf16*)(ws + WS_WIN_E), r, scr, F.lane); continue; } r -= I_INE;
        if (r < I_44) { tr_plain(F.in[7], DM, DM, (bf16*)(ws + WS_WOUT_E), r, scr, F.lane); continue; } r -= I_44;
        if (r < I_INO) { tr_plain(F.in[8], DM, 8192, (bf16*)(ws + WS_WIN_O), r, scr, F.lane); continue; } r -= I_INO;
        if (r < I_LRU) { tr_lru(F.in[11], (bf16*)(ws + WS_WG), 0, r, scr, F.lane); continue; } r -= I_LRU;
        if (r < I_LRU) { tr_lru(F.in[13], (bf16*)(ws + WS_WG), 1, r, scr, F.lane); continue; } r -= I_LRU;
        if (r < I_44) { tr_plain(F.in[16], DM, DM, (bf16*)(ws + WS_WOUT_O), r, scr, F.lane); continue; } r -= I_44;
        if (r < 2 * I_GU) { const int L = r / I_GU; tr_gu(F.in[17] + (size_t)L * DM * 2 * DFF, (bf16*)(ws + WS_WGU + (size_t)L * SZ_WGU), r % I_GU, scr, F.lane); continue; } r -= 2 * I_GU;
        { const int L = r / I_D; tr_plain(F.in[20] + (size_t)L * DFF * DM, DFF, DM, (bf16*)(ws + WS_WD + (size_t)L * SZ_WD), r % I_D, scr, F.lane); }
    }
    for (int c = F.vcu * 512 + F.tid; c < DM; c += F.G * 512) { const float p = F.in[15][c]; ((float*)(ws + WS_LS8))[c] = -8.0f * (fmaxf(-p, 0.f) + log1pf(expf(-fabsf(p)))); }
    for (int m = gw; m < LTOK; m += NGW) rms_row_to_bf16(F, base_row(F, m), F.in[2], (bf16*)(ws + WS_XN) + (size_t)m * DM);
}

__device__ __forceinline__ void norm_pass(const Frame& F, const float* src, int base_is_input, const float* hin, const float* wA, const float* wB, float* hout, bf16* xn, int final_out) {
    const int gw = F.vcu * NWAVES + F.wave, NGW = F.G * NWAVES;
    for (int r = gw; r < LTOK; r += NGW) {
        if (final_out && r >= SEQ) continue;
        const GAS f32x4* sr = (const GAS f32x4*)(src + (size_t)r * DM) + F.lane;
        const GAS f32x4* br = (const GAS f32x4*)(base_is_input ? base_row(F, r) : hin + (size_t)r * DM) + F.lane;
        const GAS f32x4* wa = (const GAS f32x4*)wA + F.lane;
        f32x4 v[16]; float s = 0.f;
#pragma unroll
        for (int j = 0; j < 16; ++j) { v[j] = sr[64 * j]; s += (v[j].x * v[j].x + v[j].y * v[j].y) + (v[j].z * v[j].z + v[j].w * v[j].w); }
        const float rstd = 1.0f / sqrtf(wave_sum(s) * (1.f / DM) + NORM_EPS);
        GAS f32x4* ho = (GAS f32x4*)(hout + (size_t)r * DM) + F.lane;
        float s2 = 0.f;
#pragma unroll
        for (int j = 0; j < 16; ++j) { const f32x4 g = wa[64 * j], b = br[64 * j]; v[j] = b + v[j] * rstd * g; ho[64 * j] = v[j]; s2 += (v[j].x * v[j].x + v[j].y * v[j].y) + (v[j].z * v[j].z + v[j].w * v[j].w); if ((j & 3) == 3) asm volatile("" ::: "memory"); }
        if (xn) {
            const float rstd2 = 1.0f / sqrtf(wave_sum(s2) * (1.f / DM) + NORM_EPS);
            const GAS f32x4* wb = (const GAS f32x4*)wB + F.lane; GAS v2u* o8 = (GAS v2u*)(xn + (size_t)r * DM) + F.lane;
#pragma unroll
            for (int j = 0; j < 16; ++j) { const f32x4 g = wb[64 * j]; v2u o; o.x = pk2(v[j].x * rstd2 * g.x, v[j].y * rstd2 * g.y); o.y = pk2(v[j].z * rstd2 * g.z, v[j].w * rstd2 * g.w); o8[64 * j] = o; if ((j & 3) == 3) asm volatile("" ::: "memory"); }
        }
    }
}

__device__ __forceinline__ void ffn_act_pass(const Frame& F, const float* G, const bf16* U, const float* cw, const float* cb, bf16* ACT) {
    const int gw = F.vcu * NWAVES + F.wave, NGW = F.G * NWAVES;
    constexpr int NCG = DFF / 256, NRB = LTOK / 16;
    for (int it = gw; it < NCG * NRB; it += NGW) {
        const int rb = it / NCG, cg = it % NCG, r0 = 16 * rb, c = cg * 256 + 4 * F.lane;
        const f32x4 w0 = *(const GAS f32x4*)(cw + c), w1 = *(const GAS f32x4*)(cw + DFF + c), w2 = *(const GAS f32x4*)(cw + 2 * DFF + c), bb = *(const GAS f32x4*)(cb + c);
        f32x4 gm2 = (f32x4){0.f, 0.f, 0.f, 0.f}, gm1 = gm2;
        if (r0 != SEQ) { const int p1 = prev_row(r0), p2 = prev_row(p1); gm1 = *(const GAS f32x4*)(G + (size_t)p1 * DFF + c); gm2 = *(const GAS f32x4*)(G + (size_t)p2 * DFF + c); }
#pragma unroll 4
        for (int i = 0; i < 16; ++i) { const size_t off = (size_t)(r0 + i) * DFF + c;
            const f32x4 g = *(const GAS f32x4*)(G + off); const v2u uu = *(const GAS v2u*)(U + off);
            const f32x4 v = bb + w0 * gm2 + w1 * gm1 + w2 * g;
            v2u o; o.x = pk2(fgelu_tanh(v.x) * bflo(uu.x), fgelu_tanh(v.y) * bfhi(uu.x)); o.y = pk2(fgelu_tanh(v.z) * bflo(uu.y), fgelu_tanh(v.w) * bfhi(uu.y));
            *(GAS v2u*)(ACT + off) = o; gm2 = gm1; gm1 = g; }
    }
}

__device__ __forceinline__ void lru_conv_pass(const Frame& F, const float* X, const float* cw, const float* cb, float* XC, bf16* XCB) {
    const int gw = F.vcu * NWAVES + F.wave, NGW = F.G * NWAVES;
    constexpr int NCG = DM / 256, NRB = LTOK / 16;
    for (int it = gw; it < NCG * NRB; it += NGW) {
        const int rb = it / NCG, cg = it % NCG, r0 = 16 * rb, c = cg * 256 + 4 * F.lane;
        const f32x4 w0 = *(const GAS f32x4*)(cw + c), w1 = *(const GAS f32x4*)(cw + DM + c), w2 = *(const GAS f32x4*)(cw + 2 * DM + c), w3 = *(const GAS f32x4*)(cw + 3 * DM + c), bb = *(const GAS f32x4*)(cb + c);
        f32x4 x3 = (f32x4){0.f, 0.f, 0.f, 0.f}, x2 = x3, x1 = x3;
        if (r0 != SEQ) { const int p1 = prev_row(r0), p2 = prev_row(p1), p3 = prev_row(p2);
            x1 = *(const GAS f32x4*)(X + (size_t)p1 * DM + c); x2 = *(const GAS f32x4*)(X + (size_t)p2 * DM + c); x3 = *(const GAS f32x4*)(X + (size_t)p3 * DM + c); }
#pragma unroll 4
        for (int i = 0; i < 16; ++i) { const size_t off = (size_t)(r0 + i) * DM + c;
            const f32x4 x = *(const GAS f32x4*)(X + off);
            const f32x4 v = bb + w0 * x3 + w1 * x2 + w2 * x1 + w3 * x;
            *(GAS f32x4*)(XC + off) = v; v2u o; o.x = pk2(v.x, v.y); o.y = pk2(v.z, v.w); *(GAS v2u*)(XCB + off) = o;
            x3 = x2; x2 = x1; x1 = x; }
    }
}

__device__ __forceinline__ void seg_rows(int s, int& r0, int& n) { if (s == 0) { r0 = SEQ; n = NMETA; } else { r0 = 64 * (s - 1); n = 64; } }
__device__ __forceinline__ void lru_scan1(const Frame& F, const float* A, const float* B, float* CA, float* CB) {
    const int gw = F.vcu * NWAVES + F.wave, NGW = F.G * NWAVES;
    for (int it = gw; it < NCHUNK * 16; it += NGW) {
        const int s = it >> 4, c = (it & 15) * 256 + 4 * F.lane; int r0, n; seg_rows(s, r0, n);
        f32x4 pa = (f32x4){1.f, 1.f, 1.f, 1.f}, h = (f32x4){0.f, 0.f, 0.f, 0.f};
#pragma unroll 8
        for (int i = 0; i < n; ++i) { const size_t off = (size_t)(r0 + i) * DM + c; const f32x4 a = *(const GAS f32x4*)(A + off), b = *(const GAS f32x4*)(B + off); h = a * h + b; pa = pa * a; }
        *(GAS f32x4*)(CA + (size_t)s * DM + c) = pa; *(GAS f32x4*)(CB + (size_t)s * DM + c) = h;
    }
}
__device__ __forceinline__ void lru_scan2(const Frame& F, const float* A, const float* B, const float* CA, const float* CB, const bf16* Y, bf16* LO) {
    const int gw = F.vcu * NWAVES + F.wave, NGW = F.G * NWAVES;
    for (int it = gw; it < NCHUNK * 16; it += NGW) {
        const int s = it >> 4, c = (it & 15) * 256 + 4 * F.lane; int r0, n; seg_rows(s, r0, n);
        f32x4 h = (f32x4){0.f, 0.f, 0.f, 0.f};
#pragma unroll 8
        for (int j = 0; j < s; ++j) { const f32x4 a = *(const GAS f32x4*)(CA + (size_t)j * DM + c), b = *(const GAS f32x4*)(CB + (size_t)j * DM + c); h = a * h + b; }
#pragma unroll 8
        for (int i = 0; i < n; ++i) { const size_t off = (size_t)(r0 + i) * DM + c; const f32x4 a = *(const GAS f32x4*)(A + off), b = *(const GAS f32x4*)(B + off); const v2u yy = *(const GAS v2u*)(Y + off);
            h = a * h + b; v2u o; o.x = pk2(h.x * bflo(yy.x), h.y * bfhi(yy.x)); o.y = pk2(h.z * bflo(yy.y), h.w * bfhi(yy.y)); *(GAS v2u*)(LO + off) = o; }
    }
}
__device__ __forceinline__ f32x4 mma_nt(const LAS bf16* A, int lda, const LAS bf16* B, int ldb, int nks, f32x4 acc, int lane) {
    const LAS bf16* ap = A + (lane & 15) * lda + 8 * (lane >> 4); const LAS bf16* bp = B + (lane & 15) * ldb + 8 * (lane >> 4);
    for (int ks = 0; ks < nks; ++ks) { const bf16x8 a = *(const LAS bf16x8*)(ap + 32 * ks), b = *(const LAS bf16x8*)(bp + 32 * ks); acc = __builtin_amdgcn_mfma_f32_16x16x32_bf16(a, b, acc, 0, 0, 0); }
    return acc;
}
__device__ __forceinline__ int hg_row(int n, int t) { return n == 0 ? (t < 48 ? -1 : SEQ + t - 48) : 64 * (n - 1) + t; }
__device__ __forceinline__ void hg_load_vt(const bf16* VA, int hh, int n, LAS bf16* VT, int tid) {
    const int t = tid >> 3, vs = (tid & 7) * 16, r = hg_row(n, t);
    v4u a = (v4u){0u, 0u, 0u, 0u}, b = a;
    if (r >= 0) { const GAS v4u* p = (const GAS v4u*)(VA + (size_t)r * 2048 + hh * 128 + vs); a = p[0]; b = p[1]; }
    const unsigned w[8] = {a.x, a.y, a.z, a.w, b.x, b.y, b.z, b.w};
#pragma unroll
    for (int j = 0; j < 8; ++j) { VT[(vs + 2 * j) * 72 + t] = (bf16)(w[j] & 0xffffu); VT[(vs + 2 * j + 1) * 72 + t] = (bf16)(w[j] >> 16); }
}
__device__ __forceinline__ void hgrn_h1(const Frame& F, const float* GL, const bf16* VA, float* US, float* DS) {
    LAS bf16* KT = (LAS bf16*)(F.lds + 0);
    LAS bf16* VT = (LAS bf16*)(F.lds + 18432);
    LAS float* TOT = (LAS float*)(F.lds + 36864);
    const int tid = F.tid, lane = F.lane, w = F.wave, k = tid & 127, sc = tid >> 7;
    for (int unit = F.vcu; unit < A_HEADS * NCHUNK; unit += F.G) {
        const int hh = unit / NCHUNK, n = unit % NCHUNK;
        float g[16], cs[16]; float run = 0.f;
#pragma unroll
        for (int i = 0; i < 16; ++i) { const int r = hg_row(n, 16 * sc + i); g[i] = r >= 0 ? GL[(size_t)r * 2048 + hh * 128 + k] : 0.f; }
#pragma unroll
        for (int i = 0; i < 16; ++i) { run += g[i]; cs[i] = run; }
        TOT[sc * 128 + k] = run;
        hg_load_vt(VA, hh, n, VT, tid);
        __syncthreads();
        float off = 0.f, total = 0.f;
#pragma unroll
        for (int j = 0; j < 4; ++j) { const float tj = TOT[j * 128 + k]; off += (j < sc) ? tj : 0.f; total += tj; }
        unsigned pk[8];
#pragma unroll
        for (int i = 0; i < 8; ++i) { const float e0 = (1.0f - fexp(g[2 * i])) * fexp(total - off - cs[2 * i]), e1 = (1.0f - fexp(g[2 * i + 1])) * fexp(total - off - cs[2 * i + 1]); pk[i] = pk2(e0, e1); }
        *(LAS v4u*)(KT + k * 72 + 16 * sc) = (v4u){pk[0], pk[1], pk[2], pk[3]}; *(LAS v4u*)(KT + k * 72 + 16 * sc + 8) = (v4u){pk[4], pk[5], pk[6], pk[7]};
        if (sc == 0) DS[(size_t)unit * 128 + k] = fexp(total);
        __syncthreads();
        float* up = US + (size_t)unit * 16384 + (size_t)(16 * w + 4 * (lane >> 4)) * 128 + (lane & 15);
#pragma unroll
        for (int vb = 0; vb < 8; ++vb) { f32x4 acc = (f32x4){0.f, 0.f, 0.f, 0.f}; acc = mma_nt(KT + 16 * w * 72, 72, VT + 16 * vb * 72, 72, 2, acc, lane);
#pragma unroll
            for (int rg = 0; rg < 4; ++rg) up[rg * 128 + 16 * vb] = acc[rg]; }
        __syncthreads();
    }
}
__device__ __forceinline__ void hgrn_h2(const Frame& F, float* US, const float* DS) {
    const int e = F.vcu * 512 + F.tid;
    for (int idx = e; idx < A_HEADS * 16384; idx += F.G * 512) {
        const int hh = idx >> 14, kv = idx & 16383, k = kv >> 7; float S = 0.f;
        float* p = US + (size_t)hh * NCHUNK * 16384 + kv; const float* d = DS + (size_t)hh * NCHUNK * 128 + k;
#pragma unroll 4
        for (int n = 0; n < NCHUNK; ++n) { const float u = p[(size_t)n * 16384], dd = d[n * 128]; p[(size_t)n * 16384] = S; S = dd * S + u; }
    }
}
__device__ __forceinline__ void hgrn_h3(const Frame& F, const float* QA, const float* GL, const float* GT, const bf16* VA, const float* US, const float* gnw, bf16* MIX) {
    LAS bf16* QS = (LAS bf16*)(F.lds + 0);
    LAS bf16* KS = (LAS bf16*)(F.lds + 17408);
    LAS bf16* VT = (LAS bf16*)(F.lds + 60928);
    LAS bf16* P  = (LAS bf16*)(F.lds + 79360);
    LAS float* TOT = (LAS float*)(F.lds + 88576);
    LAS float* OB = (LAS float*)(F.lds + 90624);
    const int tid = F.tid, lane = F.lane, w = F.wave, k = tid & 127, sc = tid >> 7;
    for (int unit = F.vcu; unit < A_HEADS * NCHUNK; unit += F.G) {
        const int hh = unit / NCHUNK, n = unit % NCHUNK;
        float g[16], q[16], cs[16]; float run = 0.f;
#pragma unroll
        for (int i = 0; i < 16; ++i) { const int r = hg_row(n, 16 * sc + i); const size_t o = (size_t)(r >= 0 ? r : 0) * 2048 + hh * 128 + k; g[i] = r >= 0 ? GL[o] : 0.f; q[i] = r >= 0 ? QA[o] : 0.f; }
#pragma unroll
        for (int i = 0; i < 16; ++i) { run += g[i]; cs[i] = run; }
        TOT[sc * 128 + k] = run;
        hg_load_vt(VA, hh, n, VT, tid);
        for (int i = tid; i < 64 * 72 / 2; i += 512) ((LAS unsigned*)P)[i] = 0u;
        __syncthreads();
        float R[4]; { float a = 0.f;
#pragma unroll
            for (int j = 0; j < 4; ++j) { R[j] = a; a += TOT[j * 128 + k]; } }
        float off = 0.f;
#pragma unroll
        for (int j = 0; j < 4; ++j) off = (j == sc) ? R[j] : off;
#pragma unroll
        for (int i = 0; i < 16; ++i) QS[(16 * sc + i) * 136 + k] = (bf16)f2bf(q[i] * fexp(cs[i]));
#pragma unroll
        for (int i2 = 0; i2 < 4; ++i2) if (i2 >= sc) { const int base = (i2 * (i2 + 1) / 2) * 16; const float rr = R[i2] - off;
#pragma unroll
            for (int i = 0; i < 16; ++i) KS[(base + 16 * sc + i) * 136 + k] = (bf16)f2bf((1.0f - fexp(g[i])) * fexp(rr - cs[i])); }
        __syncthreads();
        for (int b = w; b < 10; b += 8) { const int i = b >= 6 ? 3 : (b >= 3 ? 2 : (b >= 1 ? 1 : 0)), j = b - i * (i + 1) / 2, base = (i * (i + 1) / 2) * 16;
            f32x4 acc = (f32x4){0.f, 0.f, 0.f, 0.f}; acc = mma_nt(QS + 16 * i * 136, 136, KS + (base + 16 * j) * 136, 136, 4, acc, lane);
#pragma unroll
            for (int rg = 0; rg < 4; ++rg) { const int tr = 4 * (lane >> 4) + rg, sccol = lane & 15; const float v = (j < i || sccol <= tr) ? acc[rg] : 0.f; P[(16 * i + tr) * 72 + 16 * j + sccol] = (bf16)f2bf(v); } }
        __syncthreads();
#pragma unroll
        for (int i = 0; i < 16; ++i) QS[(16 * sc + i) * 136 + k] = (bf16)f2bf(q[i] * fexp(cs[i] + off));
        { LAS bf16* ST = KS; const int kk = tid >> 2, vq = tid & 3; const float* sp = US + (size_t)unit * 16384 + (size_t)kk * 128 + vq * 32;
#pragma unroll
            for (int j = 0; j < 8; ++j) { const f32x4 s = *(const GAS f32x4*)(sp + 4 * j);
#pragma unroll
                for (int e = 0; e < 4; ++e) ST[(vq * 32 + 4 * j + e) * 136 + kk] = (bf16)f2bf(s[e]); } }
        __syncthreads();
        { const LAS bf16* ST = KS; const int tb = w >> 1, vb0 = 4 * (w & 1);
#pragma unroll
            for (int vb = 0; vb < 4; ++vb) { f32x4 acc = (f32x4){0.f, 0.f, 0.f, 0.f};
                acc = mma_nt(QS + 16 * tb * 136, 136, ST + 16 * (vb0 + vb) * 136, 136, 4, acc, lane);
                acc = mma_nt(P + 16 * tb * 72, 72, VT + 16 * (vb0 + vb) * 72, 72, 2, acc, lane);
#pragma unroll
                for (int rg = 0; rg < 4; ++rg) OB[(16 * tb + 4 * (lane >> 4) + rg) * 128 + 16 * (vb0 + vb) + (lane & 15)] = acc[rg]; } }
        __syncthreads();
        for (int i = 0; i < 8; ++i) { const int t = 8 * w + i, r = hg_row(n, t); if (r < 0) continue;
            const f32x2 o = *(const LAS f32x2*)(OB + t * 128 + 2 * lane); const float ss = wave_sum(o.x * o.x + o.y * o.y); const float rstd = 1.0f / sqrtf(ss * (1.f / 128.f) + NORM_EPS);
            const f32x2 gt = *(const GAS f32x2*)(GT + (size_t)r * 2048 + hh * 128 + 2 * lane), gw2 = *(const GAS f32x2*)(gnw + 2 * lane);
            *(GAS unsigned*)(MIX + (size_t)r * DM + hh * 128 + 2 * lane) = pk2(o.x * rstd * gw2.x * gt.x, o.y * rstd * gw2.y * gt.y); }
        __syncthreads();
    }
}
__device__ __forceinline__ void attn_phase(const Frame& F, const bf16* QB, const bf16* KB, const bf16* VB, const float* sinks, bf16* MIX) {
    LAS bf16* KL = (LAS bf16*)(F.lds + 0);
    LAS bf16* VT = (LAS bf16*)(F.lds + 41472);
    const int tid = F.tid, lane = F.lane, w = F.wave, g = lane >> 4, ql = lane & 15;
    for (int unit = F.vcu; unit < 260; unit += F.G) {
        const bool meta = unit >= 256; const int kvh = meta ? unit - 256 : unit >> 6, jb = meta ? 0 : unit & 63;
        for (int pass = 0; pass < 5; ++pass) { const int key = pass * 64 + (tid >> 3), d8 = (tid & 7) * 8; if (key >= 288) break;
            int r = -1;
            if (key < 128) r = (!meta && jb >= 1) ? 128 * (jb - 1) + key : -1; else if (key < 256) r = !meta ? 128 * jb + key - 128 : -1; else if (key < 272) r = SEQ + key - 256;
            v4u kk = (v4u){0u, 0u, 0u, 0u}, vv = kk;
            if (r >= 0) { kk = *(const GAS v4u*)(KB + (size_t)r * 256 + kvh * 64 + d8); vv = *(const GAS v4u*)(VB + (size_t)r * 256 + kvh * 64 + d8); }
            *(LAS v4u*)(KL + key * 72 + d8) = kk;
            const unsigned wv[4] = {vv.x, vv.y, vv.z, vv.w};
#pragma unroll
            for (int j = 0; j < 4; ++j) { VT[(d8 + 2 * j) * 296 + key] = (bf16)(wv[j] & 0xffffu); VT[(d8 + 2 * j + 1) * 296 + key] = (bf16)(wv[j] >> 16); } }
        __syncthreads();
        if (!meta || w == 0) {
            const int qi = meta ? ql : 16 * w + ql; const int qrow = meta ? SEQ + ql : 128 * jb + qi;
            for (int g8 = 0; g8 < 8; ++g8) { const int head = kvh * 8 + g8;
                const GAS bf16x8* qp = (const GAS bf16x8*)(QB + (size_t)qrow * 2048 + head * 64 + 8 * g);
                const bf16x8 q0 = qp[0], q1 = qp[4];
                f32x4 s[18]; const float sk = sinks[head]; float mx = sk;
#pragma unroll
                for (int kb = 0; kb < 18; ++kb) { f32x4 acc = (f32x4){0.f, 0.f, 0.f, 0.f}; const LAS bf16* kp = KL + (16 * kb + ql) * 72 + 8 * g;
                    acc = __builtin_amdgcn_mfma_f32_16x16x32_bf16(*(const LAS bf16x8*)kp, q0, acc, 0, 0, 0); acc = __builtin_amdgcn_mfma_f32_16x16x32_bf16(*(const LAS bf16x8*)(kp + 32), q1, acc, 0, 0, 0);
#pragma unroll
                    for (int rg = 0; rg < 4; ++rg) { const int kk = 16 * kb + 4 * g + rg; bool ok;
                        if (meta) ok = kk >= 256 && kk < 272 && (kk - 256) <= qi; else ok = kk < 128 ? (jb >= 1 && kk >= qi + 1) : (kk < 256 ? (kk - 128 <= qi) : kk < 272);
                        acc[rg] = ok ? acc[rg] * 0.125f : -1e30f; mx = fmaxf(mx, acc[rg]); }
                    s[kb] = acc; if (kb & 1) __builtin_amdgcn_sched_barrier(0); }
                mx = fmaxf(mx, __shfl_xor(mx, 16)); mx = fmaxf(mx, __shfl_xor(mx, 32));
                float l = 0.f; bf16x8 pf[9];
#pragma unroll
                for (int pp = 0; pp < 9; ++pp) { float e[8];
#pragma unroll
                    for (int rg = 0; rg < 4; ++rg) { e[rg] = fexp(s[2 * pp][rg] - mx); e[4 + rg] = fexp(s[2 * pp + 1][rg] - mx); }
#pragma unroll
                    for (int j = 0; j < 8; ++j) l += e[j];
                    const v4u pw = (v4u){pk2(e[0], e[1]), pk2(e[2], e[3]), pk2(e[4], e[5]), pk2(e[6], e[7])}; pf[pp] = __builtin_bit_cast(bf16x8, pw); }
                l += __shfl_xor(l, 16); l += __shfl_xor(l, 32); l += fexp(sk - mx);
                const float inv = 1.0f / l;
#pragma unroll 1
                for (int db = 0; db < 4; ++db) { f32x4 acc = (f32x4){0.f, 0.f, 0.f, 0.f}; const LAS bf16* vp = VT + (16 * db + ql) * 296 + 4 * g;
#pragma unroll
                    for (int pp = 0; pp < 9; ++pp) { const v2u lo = *(const LAS v2u*)(vp + 32 * pp), hi = *(const LAS v2u*)(vp + 32 * pp + 16); const v4u av = (v4u){lo.x, lo.y, hi.x, hi.y};
                        acc = __builtin_amdgcn_mfma_f32_16x16x32_bf16(__builtin_bit_cast(bf16x8, av), pf[pp], acc, 0, 0, 0); }
                    v2u o; o.x = pk2(acc[0] * inv, acc[1] * inv); o.y = pk2(acc[2] * inv, acc[3] * inv);
                    *(GAS v2u*)(MIX + (size_t)qrow * DM + 2048 + head * 64 + 16 * db + 4 * g) = o; }
            }
        }
        __syncthreads();
    }
}
#ifndef MK_SINGLE
#define MK_SINGLE 1
#endif
constexpr int N_PHASES = 22;
#ifndef PHMASK
#define PHMASK 0xffffffu
#endif
#define EN(k) (((PHMASK) >> ((k) % 24)) & 1u)
#define IN(k) (EN(k) && lo <= (k) && (k) < hi)
#define SEAM(k) do { if (IN(k) && IN((k) + 1)) xcd_barrier(bar); } while (0)
template <int L> __device__ __forceinline__ void layer_tail(Frame& F, const XcdBarrier& bar, int lo, int hi, const bf16* mixA) {
    constexpr int pb = (L == 0) ? 5 : 16;
    unsigned char* ws = F.ws; bf16* XN = (bf16*)(ws + WS_XN); float* H = (float*)(ws + WS_H); float* Y = (float*)(ws + WS_Y); unsigned char* ar = ws + WS_AR; const float* nw = F.in[2];
        if (IN(pb)) {
            pg8::Gemm g{mixA, (const bf16*)(ws + (L == 0 ? WS_WOUT_E : WS_WOUT_O)), MP, DM, DM, DM, DM, -1}; pg8::StaticOrder S; S.init(MP, DM, F.G, (int)blockIdx.x);
            pg8::EpiF32 E{Y, DM};
            pg8::gemm_phase<pg8::EpiF32, pg8::StaticOrder, true, true>(F.lds + RING_OFF, g, S, E);
        } SEAM(pb);
        if (IN(pb + 1)) { norm_pass(F, Y, L == 0, H, nw + (size_t)(L * 4 + 1) * DM, nw + (size_t)(L * 4 + 2) * DM, H, XN, 0); } SEAM(pb + 1);
        if (IN(pb + 2)) {
            pg8::Gemm g{XN, (const bf16*)(ws + WS_WGU + (size_t)L * SZ_WGU), MP, 2 * DFF, DM, DM, DM, -1}; pg8::StaticOrder S; S.init(MP, 2 * DFF, F.G, (int)blockIdx.x);
            pg8::EpiGU E{(float*)(ar + AR_G), (bf16*)(ar + AR_U)};
            pg8::gemm_phase<pg8::EpiGU, pg8::StaticOrder, true, true>(F.lds + RING_OFF, g, S, E);
        } SEAM(pb + 2);
        if (IN(pb + 3)) { ffn_act_pass(F, (const float*)(ar + AR_G), (const bf16*)(ar + AR_U), F.in[18] + (size_t)L * 3 * DFF, F.in[19] + (size_t)L * DFF, (bf16*)(ar + AR_ACT)); } SEAM(pb + 3);
        if (IN(pb + 4)) {
            pg8::Gemm g{(const bf16*)(ar + AR_ACT), (const bf16*)(ws + WS_WD + (size_t)L * SZ_WD), MP, DM, DFF, DFF, DFF, -1}; pg8::StaticOrder S; S.init(MP, DM, F.G, (int)blockIdx.x);
            pg8::EpiF32 E{Y, DM};
            pg8::gemm_phase<pg8::EpiF32, pg8::StaticOrder, true, true>(F.lds + RING_OFF, g, S, E);
        } SEAM(pb + 4);
        if (IN(pb + 5)) {
            if (L == 0) norm_pass(F, Y, 0, H, nw + (size_t)3 * DM, nw + (size_t)4 * DM, H, XN, 0);
            else norm_pass(F, Y, 0, H, nw + (size_t)7 * DM, nullptr, F.out, nullptr, 1);
        }
        if (L == 0) SEAM(pb + 5);
}
struct Args { const float* in[21]; float* out; unsigned char* ws; int ph_lo, ph_hi; };
__global__ void __launch_bounds__(NWAVES * 64, 2) fwd_kernel(Args args) {
    extern __shared__ __attribute__((aligned(16))) unsigned char lds[];
    Frame F;
    F.lds = (LAS unsigned char*)lds;
    F.MISC = (volatile LAS unsigned*)(F.lds + MISC_OFF);
    F.tid = threadIdx.x; F.lane = F.tid & 63; F.wave = __builtin_amdgcn_readfirstlane(F.tid >> 6);
    F.G = gridDim.x; { const int bx = blockIdx.x; F.vcu = (F.G % 8 == 0) ? (bx % 8) * (F.G / 8) + bx / 8 : bx; }
    unsigned char* ws = args.ws; F.ws = ws;
    F.ctl = (gu32*)(ws + WS_CTL);
#pragma unroll
    for (int i = 0; i < 21; ++i) F.in[i] = args.in[i];
    F.out = args.out;
    for (int u = F.tid; u < (LDS_BYTES - LDSCTL_OFF) / 4; u += NWAVES * 64) ((LAS unsigned*)(F.lds + LDSCTL_OFF))[u] = 0u;
    __syncthreads();
    const int lo = args.ph_lo, hi = args.ph_hi;
    XcdBarrier bar; bar.bar = (unsigned*)(F.ctl + CW_BAR); bar.x = 0; bar.st = nullptr;
    if (hi - lo > 1) bar = xcd_barrier_post((unsigned*)(F.ctl + CW_BAR), F.MISC + 8);
    bf16* XN = (bf16*)(ws + WS_XN); float* H = (float*)(ws + WS_H); float* Y = (float*)(ws + WS_Y); unsigned char* ar = ws + WS_AR;
    const float* nw = F.in[2];

    if (IN(0)) { p0_prologue(F); } SEAM(0);

    {
        const bf16* mixA;
        {
            mixA = (const bf16*)(ar + AR_MIX);
            if (IN(1)) {
                pg8::Gemm g{XN, (const bf16*)(ws + WS_WIN_E), MP, EVEN_IN, DM, DM, DM, -1}; pg8::StaticOrder S; S.init(MP, EVEN_IN, F.G, (int)blockIdx.x);
                pg8::EpiInEven E{(float*)(ar + AR_QA), (float*)(ar + AR_GL), (float*)(ar + AR_GT), (bf16*)(ar + AR_VA), (bf16*)(ar + AR_QB), (bf16*)(ar + AR_KB), (bf16*)(ar + AR_VB), F.in[4]};
                pg8::gemm_phase<pg8::EpiInEven, pg8::StaticOrder, true, true>(F.lds + RING_OFF, g, S, E);
            } SEAM(1);
            if (IN(2)) {
                attn_phase(F, (const bf16*)(ar + AR_QB), (const bf16*)(ar + AR_KB), (const bf16*)(ar + AR_VB), F.in[6], (bf16*)(ar + AR_MIX));
                hgrn_h1(F, (const float*)(ar + AR_GL), (const bf16*)(ar + AR_VA), (float*)(ar + AR_US), (float*)(ar + AR_DS));
            } SEAM(2);
            if (IN(3)) { hgrn_h2(F, (float*)(ar + AR_US), (const float*)(ar + AR_DS)); } SEAM(3);
            if (IN(4)) { hgrn_h3(F, (const float*)(ar + AR_QA), (const float*)(ar + AR_GL), (const float*)(ar + AR_GT), (const bf16*)(ar + AR_VA), (const float*)(ar + AR_US), F.in[5], (bf16*)(ar + AR_MIX)); } SEAM(4);
        }
        layer_tail<0>(F, bar, lo, hi, mixA);
        {
            mixA = (const bf16*)(ar + AR_LO);
            if (IN(11)) {
                pg8::Gemm g{XN, (const bf16*)(ws + WS_WIN_O), MP, 8192, DM, DM, DM, -1}; pg8::StaticOrder S; S.init(MP, 8192, F.G, (int)blockIdx.x);
                pg8::EpiInOdd E{(bf16*)(ar + AR_YBR), (float*)(ar + AR_XBR)};
                pg8::gemm_phase<pg8::EpiInOdd, pg8::StaticOrder, true, true>(F.lds + RING_OFF, g, S, E);
            } SEAM(11);
            if (IN(12)) { lru_conv_pass(F, (const float*)(ar + AR_XBR), F.in[9], F.in[10], (float*)(ar + AR_XC), (bf16*)(ar + AR_XCB)); } SEAM(12);
            if (IN(13)) {
                pg8::Gemm g{(const bf16*)(ar + AR_XCB), (const bf16*)(ws + WS_WG), MP, 8192, 256, DM, 256, 1}; pg8::StaticOrder S; S.init(MP, 8192, F.G, (int)blockIdx.x);
                pg8::EpiGates E{(const float*)(ar + AR_XC), F.in[12], F.in[14], (const float*)(ws + WS_LS8), (float*)(ar + AR_A), (float*)(ar + AR_BI)};
                pg8::gemm_phase<pg8::EpiGates, pg8::StaticOrder, true, true>(F.lds + RING_OFF, g, S, E);
            } SEAM(13);
            if (IN(14)) { lru_scan1(F, (const float*)(ar + AR_A), (const float*)(ar + AR_BI), (float*)(ar + AR_CA), (float*)(ar + AR_CB)); } SEAM(14);
            if (IN(15)) { lru_scan2(F, (const float*)(ar + AR_A), (const float*)(ar + AR_BI), (const float*)(ar + AR_CA), (const float*)(ar + AR_CB), (const bf16*)(ar + AR_YBR), (bf16*)(ar + AR_LO)); } SEAM(15);
        }
        layer_tail<1>(F, bar, lo, hi, mixA);
    }
}

#ifndef DBG_STOP
#define DBG_STOP -1
#endif
__global__ void dbg_copy_h(const float4* __restrict__ h, float4* __restrict__ o, size_t n4) { for (size_t i = (size_t)blockIdx.x * blockDim.x + threadIdx.x; i < n4; i += (size_t)gridDim.x * blockDim.x) o[i] = h[i]; }
extern "C" void kernel_launch(void* const* d_in, const int* in_sizes, int n_in, void* d_out, int out_size, void* d_ws, size_t ws_size, hipStream_t stream) {
    static int grid = 0;
    if (grid == 0) {
        if (n_in != 21 || out_size != SEQ * DM || ws_size < WS_END) { fprintf(stderr, "kernel_launch: unexpected problem (n_in %d out %d ws %zu need %zu)\n", n_in, out_size, ws_size, (size_t)WS_END); grid = -1; return; }
        int dev = 0, cus = 0, per_cu = 0;
        if (hipGetDevice(&dev) != hipSuccess || hipDeviceGetAttribute(&cus, hipDeviceAttributeMultiprocessorCount, dev) != hipSuccess) { grid = -1; return; }
        if (hipFuncSetAttribute((const void*)fwd_kernel, hipFuncAttributeMaxDynamicSharedMemorySize, LDS_BYTES) != hipSuccess) { fprintf(stderr, "kernel_launch: hipFuncSetAttribute failed\n"); grid = -1; return; }
        if (hipOccupancyMaxActiveBlocksPerMultiprocessor(&per_cu, (const void*)fwd_kernel, NWAVES * 64, LDS_BYTES) != hipSuccess || per_cu < 1) fprintf(stderr, "kernel_launch: occupancy query says %d\n", per_cu);
        (void)hipGetLastError();
        grid = cus;
    }
    if (grid < 0) return;
    (void)hipMemsetAsync((char*)d_ws + WS_CTL, 0, CTL_ZERO_BYTES, stream);
    Args a{};
    for (int i = 0; i < 21; ++i) a.in[i] = (const float*)d_in[i];
    a.out = (float*)d_out; a.ws = (unsigned char*)d_ws;
#if MK_SINGLE
    a.ph_lo = 0; a.ph_hi = N_PHASES;
    hipLaunchKernelGGL(fwd_kernel, dim3(grid), dim3(NWAVES * 64), LDS_BYTES, stream, a);
#else
    const int last = (DBG_STOP >= 0) ? DBG_STOP : N_PHASES - 1;
    for (int k = 0; k <= last; ++k) { a.ph_lo = k; a.ph_hi = k + 1; hipLaunchKernelGGL(fwd_kernel, dim3(grid), dim3(NWAVES * 64), LDS_BYTES, stream, a); }
    if (DBG_STOP >= 0) hipLaunchKernelGGL(dbg_copy_h, dim3(2048), dim3(256), 0, stream, (const float4*)((const char*)d_ws + WS_H), (float4*)d_out, (size_t)SEQ * DM / 4);
#endif
}
```

```cpp
#include <hip/hip_runtime.h>
#include <cstdio>
#include <cstdint>

#define GAS __attribute__((address_space(1)))
#define LAS __attribute__((address_space(3)))
typedef unsigned short bf16;
typedef unsigned v4u __attribute__((ext_vector_type(4)));
typedef unsigned v2u __attribute__((ext_vector_type(2)));
typedef float f32x4 __attribute__((ext_vector_type(4)));
typedef float f32x2 __attribute__((ext_vector_type(2)));
typedef short bf16x8 __attribute__((ext_vector_type(8)));
typedef short bf16x4 __attribute__((ext_vector_type(4)));
typedef GAS unsigned gu32;

constexpr int DM = 4096, SEQ = 8192, NMETA = 16, LTOK = SEQ + NMETA;
constexpr int MP = 8448;
constexpr int NPAN = MP / 256;
constexpr int A_HEADS = 16, A_K = 128, A_V = 128, A_F = 2048;
constexpr int B_HD = 64, B_QH = 32, B_KVH = 4, B_GRP = 8, B_W = 2048, B_KVW = 256;
constexpr int EVEN_IN = 10752, DFF = 11008, LRU_W = 4096;
constexpr int NCHUNK = 129;
constexpr float NORM_EPS = 1e-6f;

constexpr size_t MiB = 1u << 20;
constexpr size_t WS_CTL = 0, CTL_ZERO_BYTES = 1 * MiB;
constexpr size_t SZ_WIN_E = (size_t)EVEN_IN * DM * 2, SZ_W44 = (size_t)DM * DM * 2, SZ_WIN_O = (size_t)8192 * DM * 2, SZ_WG = (size_t)8192 * 256 * 2,
                 SZ_WGU = (size_t)2 * DFF * DM * 2, SZ_WD = (size_t)DM * DFF * 2;
constexpr size_t WS_WIN_E = 1 * MiB;
constexpr size_t WS_WOUT_E = WS_WIN_E + SZ_WIN_E;
constexpr size_t WS_WIN_O = WS_WOUT_E + SZ_W44;
constexpr size_t WS_WG = WS_WIN_O + SZ_WIN_O;
constexpr size_t WS_WOUT_O = WS_WG + SZ_WG;
constexpr size_t WS_WGU = WS_WOUT_O + SZ_W44;
constexpr size_t WS_WD = WS_WGU + 2 * SZ_WGU;
constexpr size_t WS_H = WS_WD + 2 * SZ_WD;
constexpr size_t SZ_F32ROW = (size_t)MP * DM * 4, SZ_BFROW = (size_t)MP * DM * 2;
constexpr size_t WS_XN = WS_H + SZ_F32ROW;
constexpr size_t WS_Y = WS_XN + SZ_BFROW;
constexpr size_t WS_AR = WS_Y + SZ_F32ROW;
constexpr size_t AR_QA = 0;
constexpr size_t AR_GL = AR_QA + (size_t)MP * 2048 * 4;
constexpr size_t AR_GT = AR_GL + (size_t)MP * 2048 * 4;
constexpr size_t AR_VA = AR_GT + (size_t)MP * 2048 * 4;
constexpr size_t AR_QB = AR_VA + (size_t)MP * 2048 * 2;
constexpr size_t AR_KB = AR_QB + (size_t)MP * 2048 * 2;
constexpr size_t AR_VB = AR_KB + (size_t)MP * 256 * 2;
constexpr size_t AR_US = AR_VB + (size_t)MP * 256 * 2;
constexpr size_t AR_DS = AR_US + (size_t)A_HEADS * NCHUNK * 16384 * 4;
constexpr size_t AR_MIX = AR_DS + (size_t)A_HEADS * NCHUNK * 128 * 4;
constexpr size_t AR_L0_END = AR_MIX + SZ_BFROW;
constexpr size_t AR_G = 0;
constexpr size_t AR_U = AR_G + (size_t)MP * DFF * 4;
constexpr size_t AR_ACT = AR_U + (size_t)MP * DFF * 2;
constexpr size_t AR_FFN_END = AR_ACT + (size_t)MP * DFF * 2;
constexpr size_t AR_YBR = 0;
constexpr size_t AR_XBR = AR_YBR + SZ_BFROW;
constexpr size_t AR_XC = AR_XBR + SZ_F32ROW;
constexpr size_t AR_XCB = AR_XC + SZ_F32ROW;
constexpr size_t AR_A = AR_XCB + SZ_BFROW;
constexpr size_t AR_BI = AR_A + SZ_F32ROW;
constexpr size_t AR_CA = AR_BI + SZ_F32ROW;
constexpr size_t AR_CB = AR_CA + (size_t)NCHUNK * DM * 4;
constexpr size_t AR_LO = AR_CB + (size_t)NCHUNK * DM * 4;
constexpr size_t AR_L1_END = AR_LO + SZ_BFROW;
constexpr size_t AR_SIZE = (AR_FFN_END > AR_L0_END ? (AR_FFN_END > AR_L1_END ? AR_FFN_END : AR_L1_END) : (AR_L0_END > AR_L1_END ? AR_L0_END : AR_L1_END));
constexpr size_t WS_END = WS_AR + AR_SIZE;

constexpr size_t WS_LS8 = 512 * 1024;
constexpr int CW_TMO = 0, CW_CODE = 1;
constexpr int CW_BAR = 4096;

constexpr int RING_OFF = 0, RING_BYTES = 131072;
constexpr int LDSCTL_OFF = RING_BYTES, MISC_OFF = LDSCTL_OFF + 320;
constexpr int LDS_BYTES = 147456;
constexpr int NWAVES = 8;

#define RLX_AGENT __ATOMIC_RELAXED, __HIP_MEMORY_SCOPE_AGENT
#define LDS_WAIT() asm volatile("s_waitcnt lgkmcnt(0)" ::: "memory")
#define VM_WAIT() asm volatile("s_waitcnt vmcnt(0)" ::: "memory")
__device__ __forceinline__ unsigned f2bf(float f) { unsigned u = __builtin_bit_cast(unsigned, f); return (u + 0x7fffu + ((u >> 16) & 1u)) >> 16; }
__device__ __forceinline__ unsigned pk2(float lo, float hi) { return f2bf(lo) | (f2bf(hi) << 16); }
__device__ __forceinline__ float bflo(unsigned w) { return __builtin_bit_cast(float, w << 16); }
__device__ __forceinline__ float bfhi(unsigned w) { return __builtin_bit_cast(float, w & 0xffff0000u); }
__device__ __forceinline__ float bf1(bf16 h) { return __builtin_bit_cast(float, ((unsigned)h) << 16); }
__device__ __forceinline__ float fexp(float x) { return __builtin_amdgcn_exp2f(x * 1.4426950408889634f); }
__device__ __forceinline__ float frcp(float x) { return __builtin_amdgcn_rcpf(x); }
__device__ __forceinline__ float fsigmoid(float x) { return frcp(1.0f + fexp(-x)); }
__device__ __forceinline__ float fsilu(float x) { return x * fsigmoid(x); }
__device__ __forceinline__ float fgelu_tanh(float x) { const float t = 0.7978845608028654f * (x + 0.044715f * x * x * x); return x * frcp(1.0f + fexp(-2.0f * t)); }
__device__ __forceinline__ float wave_sum(float v) {
#pragma unroll
    for (int o = 1; o < 64; o <<= 1) v += __shfl_xor(v, o);
    return v;
}
namespace pg8 {
#define PG8_LAS __attribute__((address_space(3)))
typedef unsigned short bf16_t;
typedef short bf16x8 __attribute__((ext_vector_type(8)));
typedef float f32x4 __attribute__((ext_vector_type(4)));
typedef unsigned u32x4 __attribute__((ext_vector_type(4)));
constexpr int BM = 256, BK = 64, HALF = 128, HTB = HALF * BK * 2  , STAGE_BYTES = 8 * HTB, NXCD = 8, WGM = 8;

__host__ __device__ __forceinline__ int lds_byte(int r, int c) { const int st = (r >> 4) * 2 + (c >> 5), rr = r & 15, cc = c & 31, ob = rr * 64 + cc * 2; return st * 1024 + (ob ^ (((ob >> 9) & 1) << 5)); }
__host__ __device__ __forceinline__ void stage_rc(int b, int& R, int& C) { const int st = b / 1024, sb = b % 1024, swz = sb ^ (((sb >> 9) & 1) << 5); R = (st >> 1) * 16 + swz / 64; C = (st & 1) * 32 + (swz % 64) / 2; }
__host__ __device__ __forceinline__ int perm32(int rho) { const int n = rho >> 4, i = rho & 15; return 8 * (i >> 2) + 4 * n + (i & 3); }

struct Unit { int pm, pn; };
struct Gemm { const bf16_t* A; const bf16_t* Bt; int M, N, K; int lda, ldb; int acol_shift; };

struct StaticOrder {
    int nM, nN, nwg, G, c;
    __host__ __device__ void init(int M, int N, int G_, int c_) { nM = M / BM; nN = N / BM; nwg = nM * nN; G = G_; c = c_; }
    __host__ __device__ bool next(int i, Unit& u) const {
        const long L = (long)i * G + c; if (L >= nwg) return false;
        int wgid = (int)L; { const int q = nwg / NXCD, r = nwg % NXCD, xcd = wgid % NXCD, off = wgid / NXCD; wgid = (xcd < r ? xcd * (q + 1) : r * (q + 1) + (xcd - r) * q) + off; }
        const int nig = WGM * nN, gid = wgid / nig, fm = gid * WGM, gsz = (nM - fm) < WGM ? (nM - fm) : WGM;
        u.pm = fm + ((wgid % nig) % gsz); u.pn = (wgid % nig) / gsz; return true;
    }
    __device__ __forceinline__ void a_ready(const Unit&) const {}
    __device__ __forceinline__ void done(const Unit&) const {}
};
__device__ __forceinline__ unsigned cvt_pk_bf16(float lo, float hi) { unsigned r; asm volatile("v_cvt_pk_bf16_f32 %0, %1, %2" : "=v"(r) : "v"(lo), "v"(hi)); return r; }
}
namespace pg8 {
__device__ __forceinline__ void st_f32x8(float* p, f32x4 a, f32x4 b) { *(f32x4*)p = a; *(f32x4*)(p + 4) = b; }
__device__ __forceinline__ void st_bf16x8(bf16_t* p, f32x4 a, f32x4 b) { u32x4 w; w.x = cvt_pk_bf16(a[0], a[1]); w.y = cvt_pk_bf16(a[2], a[3]); w.z = cvt_pk_bf16(b[0], b[1]); w.w = cvt_pk_bf16(b[2], b[3]); *(u32x4*)p = w; }

struct EpiF32 {
    static constexpr bool PERM = true, AFTER_DRAIN = false;
    float* C; int ldc;
    __device__ __forceinline__ void operator()(const f32x4 (&acc)[2][2][4][2], const Unit& u, int wr, int wc, int fr, int fq) const {
        const unsigned lo = (unsigned)((wr * 64 + fr) * ldc + wc * 32 + 8 * fq);
#pragma unroll
        for (int ai = 0; ai < 2; ++ai)
#pragma unroll
            for (int m = 0; m < 4; ++m) { float* rowp = C + (size_t)(u.pm * BM + ai * HALF + m * 16) * ldc + u.pn * BM;
#pragma unroll
                for (int bj = 0; bj < 2; ++bj) st_f32x8(rowp + lo + bj * HALF, acc[ai][bj][m][0], acc[ai][bj][m][1]); }
    }
};

struct EpiInEven {
    static constexpr bool PERM = true, AFTER_DRAIN = false;
    float* QA; float* GL; float* GT; bf16_t* VA; bf16_t* QB; bf16_t* KB; bf16_t* VB; const float* lbl;
    __device__ __forceinline__ void operator()(const f32x4 (&acc)[2][2][4][2], const Unit& u, int wr, int wc, int fr, int fq) const {
        const int seg = u.pn >> 3; const int cu = (u.pn & 7) * BM;
        const unsigned lc = (unsigned)(wc * 32 + 8 * fq);
        const unsigned lo = (unsigned)((wr * 64 + fr) * 2048) + lc;
        if (seg == 0 || seg == 3) {
            float* D = (seg == 0 ? QA : GT) + (size_t)(u.pm * BM) * 2048 + cu;
#pragma unroll
            for (int ai = 0; ai < 2; ++ai)
#pragma unroll
                for (int m = 0; m < 4; ++m) { float* rowp = D + (size_t)(ai * HALF + m * 16) * 2048;
#pragma unroll
                    for (int bj = 0; bj < 2; ++bj) { f32x4 a = acc[ai][bj][m][0], b = acc[ai][bj][m][1];
#pragma unroll
                        for (int j = 0; j < 4; ++j) { a[j] = fsilu(a[j]); b[j] = fsilu(b[j]); }
                        st_f32x8(rowp + lo + bj * HALF, a, b); } }
        } else if (seg == 1) {
            f32x4 lb[2][2];
#pragma unroll
            for (int bj = 0; bj < 2; ++bj)
#pragma unroll
                for (int n = 0; n < 2; ++n) { const f32x4 l0 = *(const f32x4*)(lbl + cu + lc + bj * HALF + 4 * n), l1 = *(const f32x4*)(lbl + 2048 + cu + lc + bj * HALF + 4 * n);
#pragma unroll
                    for (int j = 0; j < 4; ++j) lb[bj][n][j] = frcp(1.0f + fexp(l1[j] - l0[j])); }
            float* D = GL + (size_t)(u.pm * BM) * 2048 + cu;
#pragma unroll
            for (int ai = 0; ai < 2; ++ai)
#pragma unroll
                for (int m = 0; m < 4; ++m) { float* rowp = D + (size_t)(ai * HALF + m * 16) * 2048;
#pragma unroll
                    for (int bj = 0; bj < 2; ++bj) { f32x4 a = acc[ai][bj][m][0], b = acc[ai][bj][m][1];
#pragma unroll
                        for (int j = 0; j < 4; ++j) { a[j] = __logf(lb[bj][0][j] + (1.0f - lb[bj][0][j]) * fsigmoid(a[j])); b[j] = __logf(lb[bj][1][j] + (1.0f - lb[bj][1][j]) * fsigmoid(b[j])); }
                        st_f32x8(rowp + lo + bj * HALF, a, b); } }
        } else if (seg == 2 || seg == 4) {
            bf16_t* D = (seg == 2 ? VA : QB) + (size_t)(u.pm * BM) * 2048 + cu;
#pragma unroll
            for (int ai = 0; ai < 2; ++ai)
#pragma unroll
                for (int m = 0; m < 4; ++m) { bf16_t* rowp = D + (size_t)(ai * HALF + m * 16) * 2048;
#pragma unroll
                    for (int bj = 0; bj < 2; ++bj) st_bf16x8(rowp + lo + bj * HALF, acc[ai][bj][m][0], acc[ai][bj][m][1]); }
        } else {
            bf16_t* D = ((u.pn == 40) ? KB : VB) + (size_t)(u.pm * BM) * 256; const unsigned lo2 = (unsigned)((wr * 64 + fr) * 256) + lc;
#pragma unroll
            for (int ai = 0; ai < 2; ++ai)
#pragma unroll
                for (int m = 0; m < 4; ++m) { bf16_t* rowp = D + (size_t)(ai * HALF + m * 16) * 256;
#pragma unroll
                    for (int bj = 0; bj < 2; ++bj) st_bf16x8(rowp + lo2 + bj * HALF, acc[ai][bj][m][0], acc[ai][bj][m][1]); }
        }
    }
};

struct EpiGU {
    static constexpr bool PERM = true, AFTER_DRAIN = false;
    float* G; bf16_t* U;
    __device__ __forceinline__ void operator()(const f32x4 (&acc)[2][2][4][2], const Unit& u, int wr, int wc, int fr, int fq) const {
        const unsigned lo = (unsigned)((wr * 64 + fr) * DFF + wc * 32 + 8 * fq);
#pragma unroll
        for (int ai = 0; ai < 2; ++ai)
#pragma unroll
            for (int m = 0; m < 4; ++m) { const size_t ro = (size_t)(u.pm * BM + ai * HALF + m * 16) * DFF + u.pn * HALF;
                st_f32x8(G + ro + lo, acc[ai][0][m][0], acc[ai][0][m][1]); st_bf16x8(U + ro + lo, acc[ai][1][m][0], acc[ai][1][m][1]); }
    }
};

struct EpiInOdd {
    static constexpr bool PERM = true, AFTER_DRAIN = false;
    bf16_t* Y; float* X;
    __device__ __forceinline__ void operator()(const f32x4 (&acc)[2][2][4][2], const Unit& u, int wr, int wc, int fr, int fq) const {
        const unsigned lo = (unsigned)((wr * 64 + fr) * DM + wc * 32 + 8 * fq);
        if (u.pn < 16) {
#pragma unroll
            for (int ai = 0; ai < 2; ++ai)
#pragma unroll
                for (int m = 0; m < 4; ++m) { bf16_t* rowp = Y + (size_t)(u.pm * BM + ai * HALF + m * 16) * DM + (u.pn & 15) * BM;
#pragma unroll
                    for (int bj = 0; bj < 2; ++bj) { f32x4 a = acc[ai][bj][m][0], b = acc[ai][bj][m][1];
#pragma unroll
                        for (int j = 0; j < 4; ++j) { a[j] = fgelu_tanh(a[j]); b[j] = fgelu_tanh(b[j]); }
                        st_bf16x8(rowp + lo + bj * HALF, a, b); } }
        } else {
#pragma unroll
            for (int ai = 0; ai < 2; ++ai)
#pragma unroll
                for (int m = 0; m < 4; ++m) { float* rowp = X + (size_t)(u.pm * BM + ai * HALF + m * 16) * DM + (u.pn & 15) * BM;
#pragma unroll
                    for (int bj = 0; bj < 2; ++bj) st_f32x8(rowp + lo + bj * HALF, acc[ai][bj][m][0], acc[ai][bj][m][1]); }
        }
    }
};

struct EpiGates {
    static constexpr bool PERM = true, AFTER_DRAIN = false;
    const float* XC; const float* ba; const float* bx; const float* ls8; float* A; float* BI;
    __device__ __forceinline__ void operator()(const f32x4 (&acc)[2][2][4][2], const Unit& u, int wr, int wc, int fr, int fq) const {
        const int chu = (u.pn >> 1) * BM + (u.pn & 1) * HALF; const unsigned lc = (unsigned)(wc * 32 + 8 * fq), lo = (unsigned)((wr * 64 + fr) * DM) + lc;
        f32x4 vba[2], vbx[2], vls[2];
#pragma unroll
        for (int n = 0; n < 2; ++n) { vba[n] = *(const f32x4*)(ba + chu + lc + 4 * n); vbx[n] = *(const f32x4*)(bx + chu + lc + 4 * n); vls[n] = *(const f32x4*)(ls8 + chu + lc + 4 * n); }
#pragma unroll
        for (int ai = 0; ai < 2; ++ai)
#pragma unroll
            for (int m = 0; m < 4; ++m) { const size_t ro = (size_t)(u.pm * BM + ai * HALF + m * 16) * DM + chu;
#pragma unroll
                for (int n = 0; n < 2; ++n) {
                    const f32x4 x = *(const f32x4*)(XC + ro + lo + 4 * n); f32x4 a, b;
#pragma unroll
                    for (int j = 0; j < 4; ++j) { const float la = vls[n][j] * fsigmoid(acc[ai][0][m][n][j] + vba[n][j]); const float t = 2.0f * la;
                        const float ser = t * (1.0f + 0.5f * t * (1.0f + (1.0f / 3.0f) * t * (1.0f + 0.25f * t * (1.0f + 0.2f * t * (1.0f + (1.0f / 6.0f) * t)))));
                        const float em1 = t > -0.25f ? ser : fexp(t) - 1.0f;
                        a[j] = fexp(la); b[j] = __builtin_sqrtf(-em1) * (fsigmoid(acc[ai][1][m][n][j] + vbx[n][j]) * x[j]); }
                    *(f32x4*)(A + ro + lo + 4 * n) = a; *(f32x4*)(BI + ro + lo + 4 * n) = b; }
                asm volatile("" ::: "memory"); }
    }
};
}
namespace pg8 {
template <class Epi, class Sched, bool ALIGN_EPI = false, bool SP2 = false>
__device__ __forceinline__ void gemm_phase(PG8_LAS unsigned char* lds, const Gemm g, const Sched& S, const Epi& E) {
    const int tid = threadIdx.x, wid = __builtin_amdgcn_readfirstlane(tid >> 6), lane = tid & 63, wr = wid >> 2, wc = wid & 3, fr = lane & 15, fq = lane >> 4;
    const int K = g.K, nt = K / BK;
    unsigned voffA[2], voffB[2];
#pragma unroll
    for (int i = 0; i < 2; ++i) { int R, C; stage_rc(tid * 16 + i * 8192, R, C); const int Rb = Epi::PERM ? ((R & ~31) + perm32(R & 31)) : R;
        voffA[i] = (unsigned)(R * g.lda + C) * 2u; voffB[i] = (unsigned)(Rb * g.ldb + C) * 2u; }
    const size_t kstep = (size_t)(BK * 2);
    const size_t hstepA = (size_t)HALF * g.lda * 2, hstepB = (size_t)HALF * g.ldb * 2;
    const size_t tstepA = 2 * hstepA, tstepB = 2 * hstepB;
#define PG8_ABASE(u) ((const char*)g.A + (size_t)(u).pm * tstepA + (g.acol_shift >= 0 ? (size_t)(((u).pn >> g.acol_shift) * 512) : (size_t)0))
    const unsigned ldsw = (unsigned)wid * 1024u;
    const int aoff = lds_byte(wr * 64 + fr, fq * 8), boff = lds_byte(wc * 32 + fr, fq * 8);
#define PG8_SA(b, h) (((b) * 2 + (h)) * HTB)
#define PG8_SB(b, h) ((4 + (b) * 2 + (h)) * HTB)
#define PG8_STAGE(bufoff, gbase, voff) do { _Pragma("unroll") for (int _i = 0; _i < 2; ++_i) \
        __builtin_amdgcn_global_load_lds((const unsigned*)((const char*)(gbase) + (voff)[_i]), (PG8_LAS unsigned*)(lds + (bufoff) + ldsw + _i * 8192), 16, 0, 0); } while (0)
#define PG8_LDA(dst, b, h) do { _Pragma("unroll") for (int m = 0; m < 4; ++m) _Pragma("unroll") for (int k = 0; k < 2; ++k) dst[m][k] = *(const PG8_LAS bf16x8*)(lds + PG8_SA(b, h) + aoff + m * 2048 + k * 1024); } while (0)
#define PG8_LDB(dst, b, h) do { _Pragma("unroll") for (int n = 0; n < 2; ++n) _Pragma("unroll") for (int k = 0; k < 2; ++k) dst[n][k] = *(const PG8_LAS bf16x8*)(lds + PG8_SB(b, h) + boff + n * 2048 + k * 1024); } while (0)
#define PG8_MMA(ai, bj, At, Bt) do { __builtin_amdgcn_s_setprio(1); _Pragma("unroll") for (int m = 0; m < 4; ++m) _Pragma("unroll") for (int n = 0; n < 2; ++n) _Pragma("unroll") for (int k = 0; k < 2; ++k) \
        acc[ai][bj][m][n] = __builtin_amdgcn_mfma_f32_16x16x32_bf16(Bt[n][k], At[m][k], acc[ai][bj][m][n], 0, 0, 0); __builtin_amdgcn_s_setprio(0); } while (0)
#define PG8_WAIT_V(n) asm volatile("s_waitcnt vmcnt(" #n ")" ::: "memory")
#define PG8_WAIT_L(n) asm volatile("s_waitcnt lgkmcnt(" #n ")" ::: "memory")
#define PG8_BAR __builtin_amdgcn_s_barrier()
#define PG8_SCHED __builtin_amdgcn_sched_barrier(0)
    Unit cur, nxt; int ui = 0;
    if (!S.next(0, cur)) return;
    f32x4 acc[2][2][4][2];
#pragma unroll
    for (int a = 0; a < 2; ++a)
#pragma unroll
        for (int b = 0; b < 2; ++b)
#pragma unroll
            for (int m = 0; m < 4; ++m)
#pragma unroll
                for (int n = 0; n < 2; ++n) acc[a][b][m][n] = (f32x4){0.f, 0.f, 0.f, 0.f};
    bf16x8 At[4][2], B0[2][2], B1[2][2];
    const char* cA = PG8_ABASE(cur); const char* cB = (const char*)g.Bt + (size_t)cur.pn * tstepB;
    S.a_ready(cur);
    if constexpr (SP2) {
        PG8_STAGE(PG8_SB(0, 0), cB, voffB); PG8_STAGE(PG8_SB(0, 1), cB + hstepB, voffB); PG8_STAGE(PG8_SA(0, 0), cA, voffA); PG8_STAGE(PG8_SA(0, 1), cA + hstepA, voffA);
        if (wr == 1) PG8_BAR;
        PG8_WAIT_V(2); PG8_BAR;
        PG8_STAGE(PG8_SB(1, 0), cB + kstep, voffB); PG8_STAGE(PG8_SA(1, 0), cA + kstep, voffA); PG8_STAGE(PG8_SB(1, 1), cB + hstepB + kstep, voffB);
        PG8_WAIT_V(6); PG8_BAR;
    } else {
        PG8_STAGE(PG8_SB(0, 0), cB, voffB); PG8_STAGE(PG8_SA(0, 0), cA, voffA); PG8_STAGE(PG8_SB(0, 1), cB + hstepB, voffB); PG8_STAGE(PG8_SA(0, 1), cA + hstepA, voffA);
        if (wr == 1) PG8_BAR;
        PG8_WAIT_V(4); PG8_BAR;
        PG8_STAGE(PG8_SB(1, 0), cB + kstep, voffB); PG8_STAGE(PG8_SA(1, 0), cA + kstep, voffA); PG8_STAGE(PG8_SB(1, 1), cB + hstepB + kstep, voffB);
        PG8_WAIT_V(6); PG8_BAR;
    }
    for (;;) {
        const bool has_next = S.next(ui + 1, nxt);
        const char* nA = has_next ? PG8_ABASE(nxt) : cA; const char* nB = has_next ? (const char*)g.Bt + (size_t)nxt.pn * tstepB : cB;
#pragma nounroll
        for (int t = 0; t < nt; t += 2) {
            const bool last = (t == nt - 2);
            const char* a1 = cA + (size_t)(t + 1) * kstep;
            const char* a2 = last ? nA : cA + (size_t)(t + 2) * kstep; const char* b2 = last ? nB : cB + (size_t)(t + 2) * kstep;
            const char* a3 = a2 + kstep; const char* b3 = b2 + kstep;
            if (last && has_next) S.a_ready(nxt);
            if constexpr (SP2) {
            PG8_LDB(B0, 0, 0); PG8_LDB(B1, 0, 1); PG8_SCHED; PG8_LDA(At, 0, 0); PG8_STAGE(PG8_SA(1, 1), a1 + hstepA, voffA);
            PG8_WAIT_V(8); PG8_WAIT_L(0); PG8_BAR; PG8_MMA(0, 0, At, B0); PG8_MMA(0, 1, At, B1); PG8_BAR; PG8_SCHED;
            PG8_LDA(At, 0, 1); PG8_STAGE(PG8_SB(0, 0), b2, voffB); PG8_STAGE(PG8_SB(0, 1), b2 + hstepB, voffB); PG8_STAGE(PG8_SA(0, 0), a2, voffA);
            PG8_WAIT_V(8); PG8_WAIT_L(0); PG8_BAR; PG8_MMA(1, 0, At, B0); PG8_MMA(1, 1, At, B1); PG8_BAR; PG8_SCHED;
            PG8_LDB(B0, 1, 0); PG8_LDB(B1, 1, 1); PG8_SCHED; PG8_LDA(At, 1, 0); PG8_STAGE(PG8_SA(0, 1), a2 + hstepA, voffA);
            PG8_WAIT_V(8); PG8_WAIT_L(0); PG8_BAR; PG8_MMA(0, 0, At, B0); PG8_MMA(0, 1, At, B1); PG8_BAR; PG8_SCHED;
            PG8_LDA(At, 1, 1); PG8_STAGE(PG8_SB(1, 0), b3, voffB); PG8_STAGE(PG8_SB(1, 1), b3 + hstepB, voffB); PG8_STAGE(PG8_SA(1, 0), a3, voffA);
            PG8_WAIT_V(8); PG8_WAIT_L(0); PG8_BAR; PG8_MMA(1, 0, At, B0); PG8_MMA(1, 1, At, B1); PG8_BAR; PG8_SCHED;
            } else {
            PG8_LDB(B0, 0, 0); PG8_SCHED; PG8_LDA(At, 0, 0); PG8_STAGE(PG8_SA(1, 1), a1 + hstepA, voffA);
            PG8_WAIT_L(8); PG8_BAR; PG8_WAIT_L(0); PG8_MMA(0, 0, At, B0); PG8_BAR; PG8_SCHED;
            PG8_LDB(B1, 0, 1); PG8_STAGE(PG8_SB(0, 0), b2, voffB);
            PG8_BAR; PG8_WAIT_L(0); PG8_MMA(0, 1, At, B1); PG8_BAR;
            PG8_LDA(At, 0, 1); PG8_STAGE(PG8_SA(0, 0), a2, voffA);
            PG8_BAR; PG8_WAIT_L(0); PG8_MMA(1, 0, At, B0); PG8_BAR; PG8_SCHED;
            PG8_STAGE(PG8_SB(0, 1), b2 + hstepB, voffB);
            PG8_WAIT_V(6); PG8_BAR; PG8_MMA(1, 1, At, B1); PG8_BAR;
            PG8_LDB(B0, 1, 0); PG8_SCHED; PG8_LDA(At, 1, 0); PG8_STAGE(PG8_SA(0, 1), a2 + hstepA, voffA);
            PG8_WAIT_L(8); PG8_BAR; PG8_WAIT_L(0); PG8_MMA(0, 0, At, B0); PG8_BAR; PG8_SCHED;
            PG8_LDB(B1, 1, 1); PG8_STAGE(PG8_SB(1, 0), b3, voffB);
            PG8_BAR; PG8_WAIT_L(0); PG8_MMA(0, 1, At, B1); PG8_BAR;
            PG8_LDA(At, 1, 1); PG8_STAGE(PG8_SA(1, 0), a3, voffA);
            PG8_BAR; PG8_WAIT_L(0); PG8_MMA(1, 0, At, B0); PG8_BAR; PG8_SCHED;
            PG8_STAGE(PG8_SB(1, 1), b3 + hstepB, voffB);
            PG8_WAIT_V(6); PG8_BAR; PG8_MMA(1, 1, At, B1); PG8_BAR;
            }
        }
        if constexpr (ALIGN_EPI) { if (wr == 0) PG8_BAR; }
        if constexpr (!Epi::AFTER_DRAIN) { E(acc, cur, wr, wc, fr, fq); S.done(cur); }
        if (!has_next) break;
#pragma unroll
        for (int a = 0; a < 2; ++a)
#pragma unroll
            for (int b = 0; b < 2; ++b)
#pragma unroll
                for (int m = 0; m < 4; ++m)
#pragma unroll
                    for (int n = 0; n < 2; ++n) acc[a][b][m][n] = (f32x4){0.f, 0.f, 0.f, 0.f};
        cur = nxt; cA = nA; cB = nB; ++ui;
        if constexpr (ALIGN_EPI) { if (wr == 1) PG8_BAR; }
    }
    PG8_WAIT_V(0);
    if constexpr (!ALIGN_EPI) { if (wr == 0) PG8_BAR; }
    PG8_BAR;
    if constexpr (Epi::AFTER_DRAIN) { E.fused(acc, cur, wr, wc, fr, fq, lds, wid, lane); S.done(cur); }
#undef PG8_ABASE
#undef PG8_SA
#undef PG8_SB
#undef PG8_STAGE
#undef PG8_LDA
#undef PG8_LDB
#undef PG8_MMA
#undef PG8_WAIT_V
#undef PG8_WAIT_L
#undef PG8_BAR
#undef PG8_SCHED
}
}
#define XB_TMO      128
#define XB_XCNT(j)  (256  + 64 * (j))
#define XB_XSUB(j)  (1280 + 64 * (j))
#define XB_XGEN(j)  (2304 + 64 * (j))
#define XB_TOP      3328
#define XB_TOPGEN   3392
#define XCD_BAR_WORDS 3456
#define XB_SPIN_CAP (1u << 18)

__device__ __forceinline__ unsigned xb_ld(unsigned* p)              { return __hip_atomic_load(p, __ATOMIC_RELAXED, __HIP_MEMORY_SCOPE_AGENT); }
__device__ __forceinline__ unsigned xb_add(unsigned* p, unsigned v) { return __hip_atomic_fetch_add(p, v, __ATOMIC_RELAXED, __HIP_MEMORY_SCOPE_AGENT); }
__device__ __forceinline__ unsigned xb_xcc_id() { return (unsigned)__builtin_amdgcn_s_getreg((3 << 11) | 20) & 0xFu; }
#define XB_SPIN(cond, bar) do { unsigned _sp = 0; while (cond) { __builtin_amdgcn_s_sleep(1); \
    if ((++_sp & 255u) == 0u) { if (xb_ld(&(bar)[XB_TMO])) break; if (_sp > XB_SPIN_CAP) { atomicAdd(&(bar)[XB_TMO], 1u); break; } } } } while (0)

struct XcdBarrier {
    unsigned* bar; unsigned x;
    volatile LAS unsigned* st;
};

__device__ __forceinline__ XcdBarrier xcd_barrier_post(unsigned* bar, volatile LAS unsigned* st) {
    XcdBarrier b; b.bar = bar; b.x = xb_xcc_id(); b.st = st;
    if (threadIdx.x == 0) (void)xb_add(&bar[XB_XCNT(b.x)], 1u);
    return b;
}
__device__ __forceinline__ void xcd_barrier_complete(unsigned* bar, unsigned x, unsigned& nloc, unsigned& nx) {
    const unsigned G = gridDim.x * gridDim.y * gridDim.z;
    unsigned sum, cnt, mine, sp = 0u;
    for (;;) {
        sum = 0u; cnt = 0u; mine = 0u;
#pragma unroll
        for (unsigned j = 0; j < 16; ++j) { const unsigned c = xb_ld(&bar[XB_XCNT(j)]); sum += c; cnt += (c > 0u) ? 1u : 0u; mine = (j == x) ? c : mine; }
        if (sum == G) break;
        __builtin_amdgcn_s_sleep(1);
        if ((++sp & 255u) == 0u) { if (xb_ld(&bar[XB_TMO])) break; if (sp > XB_SPIN_CAP) { atomicAdd(&bar[XB_TMO], 1u); break; } }
    }
    nloc = mine > 0u ? mine : 1u; nx = cnt > 0u ? cnt : 1u;
}

__device__ __forceinline__ void xcd_barrier(const XcdBarrier& b) {
    asm volatile("s_waitcnt vmcnt(0)" ::: "memory");
    __syncthreads();
    if (threadIdx.x == 0) {
        unsigned* bar = b.bar;
        __builtin_amdgcn_s_waitcnt(0);
        unsigned nloc = b.st[0], nx = b.st[1];
        if (nloc == 0u) { xcd_barrier_complete(bar, b.x, nloc, nx); b.st[0] = nloc; b.st[1] = nx; }
        const unsigned old = xb_add(&bar[XB_XSUB(b.x)], 1u);
        const unsigned gen = old / nloc;
        if (old + 1u == (gen + 1u) * nloc) {
            __builtin_amdgcn_fence(__ATOMIC_RELEASE, "agent");
            asm volatile("s_waitcnt vmcnt(0)" ::: "memory");
            const unsigned og = xb_add(&bar[XB_TOP], 1u);
            const unsigned tg = og / nx;
            if (og + 1u == (tg + 1u) * nx) xb_add(&bar[XB_TOPGEN], 1u);
            else XB_SPIN(xb_ld(&bar[XB_TOPGEN]) == tg, bar);
            __builtin_amdgcn_fence(__ATOMIC_ACQUIRE, "agent");
            xb_add(&bar[XB_XGEN(b.x)], 1u);
            asm volatile("s_waitcnt vmcnt(0)" ::: "memory");
        } else {
            XB_SPIN(xb_ld(&bar[XB_XGEN(b.x)]) == gen, bar);
            __builtin_amdgcn_fence(__ATOMIC_ACQUIRE, "agent");
            asm volatile("s_waitcnt vmcnt(0)" ::: "memory");
        }
    }
    __syncthreads();
}
struct Frame {
    LAS unsigned char* lds;
    volatile LAS unsigned* MISC;
    gu32* ctl;
    int tid, lane, wave;
    int vcu, G;
    unsigned char* ws;
    const float* in[21];
    float* out;
};
__device__ __forceinline__ int prev_row(int r) { return r == SEQ ? -1 : (r == 0 ? LTOK - 1 : r - 1); }
__device__ __forceinline__ const float* base_row(const Frame& F, int r) { return r < SEQ ? F.in[0] + (size_t)r * DM : F.in[1] + (size_t)(r - SEQ) * DM; }

__device__ __forceinline__ void transpose_item(const float* W, int N, bf16* WT, int ldk, int k0, int n0, int drow0, LAS float* scr, int lane) {
#pragma unroll 8
    for (int i = 0; i < 32; ++i) { const int kk = 2 * i + (lane >> 5); scr[kk * 33 + (lane & 31)] = W[(size_t)(k0 + kk) * N + n0 + (lane & 31)]; }
    LDS_WAIT(); asm volatile("" ::: "memory");
    const int c = lane & 7;
#pragma unroll
    for (int j = 0; j < 4; ++j) { const int n = (lane >> 3) + 8 * j; const LAS float* s = scr + (8 * c) * 33 + n;
        v4u o; o.x = pk2(s[0 * 33], s[1 * 33]); o.y = pk2(s[2 * 33], s[3 * 33]); o.z = pk2(s[4 * 33], s[5 * 33]); o.w = pk2(s[6 * 33], s[7 * 33]);
        *(GAS v4u*)(WT + (size_t)(drow0 + n) * ldk + k0 + 8 * c) = o; }
    LDS_WAIT(); asm volatile("" ::: "memory");
}
__device__ __forceinline__ void tr_plain(const float* W, int K, int N, bf16* WT, int item, LAS float* scr, int lane) {
    const int nblk = N / 32, kb = item / nblk, nb = item % nblk; transpose_item(W, N, WT, K, 64 * kb, 32 * nb, 32 * nb, scr, lane);
}
__device__ __forceinline__ void tr_gu(const float* W, bf16* WT, int item, LAS float* scr, int lane) {
    const int nblk = (2 * DFF) / 32, kb = item / nblk, nb = item % nblk, n0 = 32 * nb; const int isup = n0 >= DFF, c0 = isup ? n0 - DFF : n0;
    transpose_item(W, 2 * DFF, WT, DM, 64 * kb, n0, 256 * (c0 >> 7) + (c0 & 127) + (isup ? 128 : 0), scr, lane);
}
__device__ __forceinline__ void tr_lru(const float* W, bf16* WT, int isx, int item, LAS float* scr, int lane) {
    const int h = item >> 5, r = item & 31, kb = r >> 3, nb = r & 7, j0 = 32 * nb;
    transpose_item(W + (size_t)h * 65536, 256, WT, 256, 64 * kb, j0, 256 * (2 * h + (j0 >> 7)) + (j0 & 127) + (isx ? 128 : 0), scr, lane);
}
__device__ __forceinline__ void rms_row_to_bf16(const Frame& F, const float* xrow, const float* w, bf16* orow) {
    const GAS f32x4* xr = (const GAS f32x4*)xrow + F.lane; const GAS f32x4* wr = (const GAS f32x4*)w + F.lane;
    f32x4 v[16]; float s = 0.f;
#pragma unroll
    for (int j = 0; j < 16; ++j) { v[j] = xr[64 * j]; s += (v[j].x * v[j].x + v[j].y * v[j].y) + (v[j].z * v[j].z + v[j].w * v[j].w); }
    const float rstd = 1.0f / sqrtf(wave_sum(s) * (1.f / DM) + NORM_EPS);
    GAS v2u* o8 = (GAS v2u*)orow + F.lane;
#pragma unroll
    for (int j = 0; j < 16; ++j) { const f32x4 g = wr[64 * j]; v2u o; o.x = pk2(v[j].x * rstd * g.x, v[j].y * rstd * g.y); o.y = pk2(v[j].z * rstd * g.z, v[j].w * rstd * g.w); o8[64 * j] = o; }
}
__device__ __forceinline__ void p0_prologue(Frame& F) {
    LAS float* scr = (LAS float*)(F.lds + RING_OFF + F.wave * 16384);
    const int gw = F.vcu * NWAVES + F.wave, NGW = F.G * NWAVES;
    constexpr int I_INE = (DM / 64) * (EVEN_IN / 32), I_44 = (DM / 64) * (DM / 32), I_INO = (DM / 64) * (8192 / 32), I_LRU = 16 * 32, I_GU = (DM / 64) * (2 * DFF / 32), I_D = (DFF / 64) * (DM / 32);
    constexpr int NITEMS = I_INE + I_44 + I_INO + 2 * I_LRU + I_44 + 2 * I_GU + 2 * I_D;
    unsigned char* ws = F.ws;
    for (int it = gw; it < NITEMS; it += NGW) {
        int r = it;
        if (r < I_INE) { tr_plain(F.in[3], DM, EVEN_IN, (bf16*)(ws + WS_WIN_E), r, scr, F.lane); continue; } r -= I_INE;
        if (r < I_44) { tr_plain(F.in[7], DM, DM, (bf16*)(ws + WS_WOUT_E), r, scr, F.lane); continue; } r -= I_44;
        if (r < I_INO) { tr_plain(F.in[8], DM, 8192, (bf16*)(ws + WS_WIN_O), r, scr, F.lane); continue; } r -= I_INO;
        if (r < I_LRU) { tr_lru(F.in[11], (bf16*)(ws + WS_WG), 0, r, scr, F.lane); continue; } r -= I_LRU;
        if (r < I_LRU) { tr_lru(F.in[13], (bf16*)(ws + WS_WG), 1, r, scr, F.lane); continue; } r -= I_LRU;
        if (r < I_44) { tr_plain(F.in[16], DM, DM, (bf16*)(ws + WS_WOUT_O), r, scr, F.lane); continue; } r -= I_44;
        if (r < 2 * I_GU) { const int L = r / I_GU; tr_gu(F.in[17] + (size_t)L * DM * 2 * DFF, (bf16*)(ws + WS_WGU + (size_t)L * SZ_WGU), r % I_GU, scr, F.lane); continue; } r -= 2 * I_GU;
        { const int L = r / I_D; tr_plain(F.in[20] + (size_t)L * DFF * DM, DFF, DM, (bf16*)(ws + WS_WD + (size_t)L * SZ_WD), r % I_D, scr, F.lane); }
    }
    for (int c = F.vcu * 512 + F.tid; c < DM; c += F.G * 512) { const float p = F.in[15][c]; ((float*)(ws + WS_LS8))[c] = -8.0f * (fmaxf(-p, 0.f) + log1pf(expf(-fabsf(p)))); }
    for (int m = gw; m < LTOK; m += NGW) rms_row_to_bf16(F, base_row(F, m), F.in[2], (bf16*)(ws + WS_XN) + (size_t)m * DM);
}

__device__ __forceinline__ void norm_pass(const Frame& F, const float* src, int base_is_input, const float* hin, const float* wA, const float* wB, float* hout, bf16* xn, int final_out) {
    const int gw = F.vcu * NWAVES + F.wave, NGW = F.G * NWAVES;
    for (int r = gw; r < LTOK; r += NGW) {
        if (final_out && r >= SEQ) continue;
        const GAS f32x4* sr = (const GAS f32x4*)(src + (size_t)r * DM) + F.lane;
        const GAS f32x4* br = (const GAS f32x4*)(base_is_input ? base_row(F, r) : hin + (size_t)r * DM) + F.lane;
        const GAS f32x4* wa = (const GAS f32x4*)wA + F.lane;
        f32x4 v[16]; float s = 0.f;
#pragma unroll
        for (int j = 0; j < 16; ++j) { v[j] = sr[64 * j]; s += (v[j].x * v[j].x + v[j].y * v[j].y) + (v[j].z * v[j].z + v[j].w * v[j].w); }
        const float rstd = 1.0f / sqrtf(wave_sum(s) * (1.f / DM) + NORM_EPS);
        GAS f32x4* ho = (GAS f32x4*)(hout + (size_t)r * DM) + F.lane;
        float s2 = 0.f;
#pragma unroll
        for (int j = 0; j < 16; ++j) { const f32x4 g = wa[64 * j], b = br[64 * j]; v[j] = b + v[j] * rstd * g; ho[64 * j] = v[j]; s2 += (v[j].x * v[j].x + v[j].y * v[j].y) + (v[j].z * v[j].z + v[j].w * v[j].w); if ((j & 3) == 3) asm volatile("" ::: "memory"); }
        if (xn) {
            const float rstd2 = 1.0f / sqrtf(wave_sum(s2) * (1.f / DM) + NORM_EPS);
            const GAS f32x4* wb = (const GAS f32x4*)wB + F.lane; GAS v2u* o8 = (GAS v2u*)(xn + (size_t)r * DM) + F.lane;
#pragma unroll
            for (int j = 0; j < 16; ++j) { const f32x4 g = wb[64 * j]; v2u o; o.x = pk2(v[j].x * rstd2 * g.x, v[j].y * rstd2 * g.y); o.y = pk2(v[j].z * rstd2 * g.z, v[j].w * rstd2 * g.w); o8[64 * j] = o; if ((j & 3) == 3) asm volatile("" ::: "memory"); }
        }
    }
}

__device__ __forceinline__ void ffn_act_pass(const Frame& F, const float* G, const bf16* U, const float* cw, const float* cb, bf16* ACT) {
    const int gw = F.vcu * NWAVES + F.wave, NGW = F.G * NWAVES;
    constexpr int NCG = DFF / 256, NRB = LTOK / 16;
    for (int it = gw; it < NCG * NRB; it += NGW) {
        const int rb = it / NCG, cg = it % NCG, r0 = 16 * rb, c = cg * 256 + 4 * F.lane;
        const f32x4 w0 = *(const GAS f32x4*)(cw + c), w1 = *(const GAS f32x4*)(cw + DFF + c), w2 = *(const GAS f32x4*)(cw + 2 * DFF + c), bb = *(const GAS f32x4*)(cb + c);
        f32x4 gm2 = (f32x4){0.f, 0.f, 0.f, 0.f}, gm1 = gm2;
        if (r0 != SEQ) { const int p1 = prev_row(r0), p2 = prev_row(p1); gm1 = *(const GAS f32x4*)(G + (size_t)p1 * DFF + c); gm2 = *(const GAS f32x4*)(G + (size_t)p2 * DFF + c); }
#pragma unroll 4
        for (int i = 0; i < 16; ++i) { const size_t off = (size_t)(r0 + i) * DFF + c;
            const f32x4 g = *(const GAS f32x4*)(G + off); const v2u uu = *(const GAS v2u*)(U + off);
            const f32x4 v = bb + w0 * gm2 + w1 * gm1 + w2 * g;
            v2u o; o.x = pk2(fgelu_tanh(v.x) * bflo(uu.x), fgelu_tanh(v.y) * bfhi(uu.x)); o.y = pk2(fgelu_tanh(v.z) * bflo(uu.y), fgelu_tanh(v.w) * bfhi(uu.y));
            *(GAS v2u*)(ACT + off) = o; gm2 = gm1; gm1 = g; }
    }
}

__device__ __forceinline__ void lru_conv_pass(const Frame& F, const float* X, const float* cw, const float* cb, float* XC, bf16* XCB) {
    const int gw = F.vcu * NWAVES + F.wave, NGW = F.G * NWAVES;
    constexpr int NCG = DM / 256, NRB = LTOK / 16;
    for (int it = gw; it < NCG * NRB; it += NGW) {
        const int rb = it / NCG, cg = it % NCG, r0 = 16 * rb, c = cg * 256 + 4 * F.lane;
        const f32x4 w0 = *(const GAS f32x4*)(cw + c), w1 = *(const GAS f32x4*)(cw + DM + c), w2 = *(const GAS f32x4*)(cw + 2 * DM + c), w3 = *(const GAS f32x4*)(cw + 3 * DM + c), bb = *(const GAS f32x4*)(cb + c);
        f32x4 x3 = (f32x4){0.f, 0.f, 0.f, 0.f}, x2 = x3, x1 = x3;
        if (r0 != SEQ) { const int p1 = prev_row(r0), p2 = prev_row(p1), p3 = prev_row(p2);
            x1 = *(const GAS f32x4*)(X + (size_t)p1 * DM + c); x2 = *(const GAS f32x4*)(X + (size_t)p2 * DM + c); x3 = *(const GAS f32x4*)(X + (size_t)p3 * DM + c); }
#pragma unroll 4
        for (int i = 0; i < 16; ++i) { const size_t off = (size_t)(r0 + i) * DM + c;
            const f32x4 x = *(const GAS f32x4*)(X + off);
            const f32x4 v = bb + w0 * x3 + w1 * x2 + w2 * x1 + w3 * x;
            *(GAS f32x4*)(XC + off) = v; v2u o; o.x = pk2(v.x, v.y); o.y = pk2(v.z, v.w); *(GAS v2u*)(XCB + off) = o;
            x3 = x2; x2 = x1; x1 = x; }
    }
}

__device__ __forceinline__ void seg_rows(int s, int& r0, int& n) { if (s == 0) { r0 = SEQ; n = NMETA; } else { r0 = 64 * (s - 1); n = 64; } }
__device__ __forceinline__ void lru_scan1(const Frame& F, const float* A, const float* B, float* CA, float* CB) {
    const int gw = F.vcu * NWAVES + F.wave, NGW = F.G * NWAVES;
    for (int it = gw; it < NCHUNK * 16; it += NGW) {
        const int s = it >> 4, c = (it & 15) * 256 + 4 * F.lane; int r0, n; seg_rows(s, r0, n);
        f32x4 pa = (f32x4){1.f, 1.f, 1.f, 1.f}, h = (f32x4){0.f, 0.f, 0.f, 0.f};
#pragma unroll 8
        for (int i = 0; i < n; ++i) { const size_t off = (size_t)(r0 + i) * DM + c; const f32x4 a = *(const GAS f32x4*)(A + off), b = *(const GAS f32x4*)(B + off); h = a * h + b; pa = pa * a; }
        *(GAS f32x4*)(CA + (size_t)s * DM + c) = pa; *(GAS f32x4*)(CB + (size_t)s * DM + c) = h;
    }
}
__device__ __forceinline__ void lru_scan2(const Frame& F, const float* A, const float* B, const float* CA, const float* CB, const bf16* Y, bf16* LO) {
    const int gw = F.vcu * NWAVES + F.wave, NGW = F.G * NWAVES;
    for (int it = gw; it < NCHUNK * 16; it += NGW) {
        const int s = it >> 4, c = (it & 15) * 256 + 4 * F.lane; int r0, n; seg_rows(s, r0, n);
        f32x4 h = (f32x4){0.f, 0.f, 0.f, 0.f};
#pragma unroll 8
        for (int j = 0; j < s; ++j) { const f32x4 a = *(const GAS f32x4*)(CA + (size_t)j * DM + c), b = *(const GAS f32x4*)(CB + (size_t)j * DM + c); h = a * h + b; }
#pragma unroll 8
        for (int i = 0; i < n; ++i) { const size_t off = (size_t)(r0 + i) * DM + c; const f32x4 a = *(const GAS f32x4*)(A + off), b = *(const GAS f32x4*)(B + off); const v2u yy = *(const GAS v2u*)(Y + off);
            h = a * h + b; v2u o; o.x = pk2(h.x * bflo(yy.x), h.y * bfhi(yy.x)); o.y = pk2(h.z * bflo(yy.y), h.w * bfhi(yy.y)); *(GAS v2u*)(LO + off) = o; }
    }
}
__device__ __forceinline__ f32x4 mma_nt(const LAS bf16* A, int lda, const LAS bf16* B, int ldb, int nks, f32x4 acc, int lane) {
    const LAS bf16* ap = A + (lane & 15) * lda + 8 * (lane >> 4); const LAS bf16* bp = B + (lane & 15) * ldb + 8 * (lane >> 4);
    for (int ks = 0; ks < nks; ++ks) { const bf16x8 a = *(const LAS bf16x8*)(ap + 32 * ks), b = *(const LAS bf16x8*)(bp + 32 * ks); acc = __builtin_amdgcn_mfma_f32_16x16x32_bf16(a, b, acc, 0, 0, 0); }
    return acc;
}
__device__ __forceinline__ int hg_row(int n, int t) { return n == 0 ? (t < 48 ? -1 : SEQ + t - 48) : 64 * (n - 1) + t; }
__device__ __forceinline__ void hg_load_vt(const bf16* VA, int hh, int n, LAS bf16* VT, int tid) {
    const int t = tid >> 3, vs = (tid & 7) * 16, r = hg_row(n, t);
    v4u a = (v4u){0u, 0u, 0u, 0u}, b = a;
    if (r >= 0) { const GAS v4u* p = (const GAS v4u*)(VA + (size_t)r * 2048 + hh * 128 + vs); a = p[0]; b = p[1]; }
    const unsigned w[8] = {a.x, a.y, a.z, a.w, b.x, b.y, b.z, b.w};
#pragma unroll
    for (int j = 0; j < 8; ++j) { VT[(vs + 2 * j) * 72 + t] = (bf16)(w[j] & 0xffffu); VT[(vs + 2 * j + 1) * 72 + t] = (bf16)(w[j] >> 16); }
}
__device__ __forceinline__ void hgrn_h1(const Frame& F, const float* GL, const bf16* VA, float* US, float* DS) {
    LAS bf16* KT = (LAS bf16*)(F.lds + 0);
    LAS bf16* VT = (LAS bf16*)(F.lds + 18432);
    LAS float* TOT = (LAS float*)(F.lds + 36864);
    const int tid = F.tid, lane = F.lane, w = F.wave, k = tid & 127, sc = tid >> 7;
    for (int unit = F.vcu; unit < A_HEADS * NCHUNK; unit += F.G) {
        const int hh = unit / NCHUNK, n = unit % NCHUNK;
        float g[16], cs[16]; float run = 0.f;
#pragma unroll
        for (int i = 0; i < 16; ++i) { const int r = hg_row(n, 16 * sc + i); g[i] = r >= 0 ? GL[(size_t)r * 2048 + hh * 128 + k] : 0.f; }
#pragma unroll
        for (int i = 0; i < 16; ++i) { run += g[i]; cs[i] = run; }
        TOT[sc * 128 + k] = run;
        hg_load_vt(VA, hh, n, VT, tid);
        __syncthreads();
        float off = 0.f, total = 0.f;
#pragma unroll
        for (int j = 0; j < 4; ++j) { const float tj = TOT[j * 128 + k]; off += (j < sc) ? tj : 0.f; total += tj; }
        unsigned pk[8];
#pragma unroll
        for (int i = 0; i < 8; ++i) { const float e0 = (1.0f - fexp(g[2 * i])) * fexp(total - off - cs[2 * i]), e1 = (1.0f - fexp(g[2 * i + 1])) * fexp(total - off - cs[2 * i + 1]); pk[i] = pk2(e0, e1); }
        *(LAS v4u*)(KT + k * 72 + 16 * sc) = (v4u){pk[0], pk[1], pk[2], pk[3]}; *(LAS v4u*)(KT + k * 72 + 16 * sc + 8) = (v4u){pk[4], pk[5], pk[6], pk[7]};
        if (sc == 0) DS[(size_t)unit * 128 + k] = fexp(total);
        __syncthreads();
        float* up = US + (size_t)unit * 16384 + (size_t)(16 * w + 4 * (lane >> 4)) * 128 + (lane & 15);
#pragma unroll
        for (int vb = 0; vb < 8; ++vb) { f32x4 acc = (f32x4){0.f, 0.f, 0.f, 0.f}; acc = mma_nt(KT + 16 * w * 72, 72, VT + 16 * vb * 72, 72, 2, acc, lane);
#pragma unroll
            for (int rg = 0; rg < 4; ++rg) up[rg * 128 + 16 * vb] = acc[rg]; }
        __syncthreads();
    }
}
__device__ __forceinline__ void hgrn_h2(const Frame& F, float* US, const float* DS) {
    const int e = F.vcu * 512 + F.tid;
    for (int idx = e; idx < A_HEADS * 16384; idx += F.G * 512) {
        const int hh = idx >> 14, kv = idx & 16383, k = kv >> 7; float S = 0.f;
        float* p = US + (size_t)hh * NCHUNK * 16384 + kv; const float* d = DS + (size_t)hh * NCHUNK * 128 + k;
#pragma unroll 4
        for (int n = 0; n < NCHUNK; ++n) { const float u = p[(size_t)n * 16384], dd = d[n * 128]; p[(size_t)n * 16384] = S; S = dd * S + u; }
    }
}
__device__ __forceinline__ void hgrn_h3(const Frame& F, const float* QA, const float* GL, const float* GT, const bf16* VA, const float* US, const float* gnw, bf16* MIX) {
    LAS bf16* QS = (LAS bf16*)(F.lds + 0);
    LAS bf16* KS = (LAS bf16*)(F.lds + 17408);
    LAS bf16* VT = (LAS bf16*)(F.lds + 60928);
    LAS bf16* P  = (LAS bf16*)(F.lds + 79360);
    LAS float* TOT = (LAS float*)(F.lds + 88576);
    LAS float* OB = (LAS float*)(F.lds + 90624);
    const int tid = F.tid, lane = F.lane, w = F.wave, k = tid & 127, sc = tid >> 7;
    for (int unit = F.vcu; unit < A_HEADS * NCHUNK; unit += F.G) {
        const int hh = unit / NCHUNK, n = unit % NCHUNK;
        float g[16], q[16], cs[16]; float run = 0.f;
#pragma unroll
        for (int i = 0; i < 16; ++i) { const int r = hg_row(n, 16 * sc + i); const size_t o = (size_t)(r >= 0 ? r : 0) * 2048 + hh * 128 + k; g[i] = r >= 0 ? GL[o] : 0.f; q[i] = r >= 0 ? QA[o] : 0.f; }
#pragma unroll
        for (int i = 0; i < 16; ++i) { run += g[i]; cs[i] = run; }
        TOT[sc * 128 + k] = run;
        hg_load_vt(VA, hh, n, VT, tid);
        for (int i = tid; i < 64 * 72 / 2; i += 512) ((LAS unsigned*)P)[i] = 0u;
        __syncthreads();
        float R[4]; { float a = 0.f;
#pragma unroll
            for (int j = 0; j < 4; ++j) { R[j] = a; a += TOT[j * 128 + k]; } }
        float off = 0.f;
#pragma unroll
        for (int j = 0; j < 4; ++j) off = (j == sc) ? R[j] : off;
#pragma unroll
        for (int i = 0; i < 16; ++i) QS[(16 * sc + i) * 136 + k] = (bf16)f2bf(q[i] * fexp(cs[i]));
#pragma unroll
        for (int i2 = 0; i2 < 4; ++i2) if (i2 >= sc) { const int base = (i2 * (i2 + 1) / 2) * 16; const float rr = R[i2] - off;
#pragma unroll
            for (int i = 0; i < 16; ++i) KS[(base + 16 * sc + i) * 136 + k] = (bf16)f2bf((1.0f - fexp(g[i])) * fexp(rr - cs[i])); }
        __syncthreads();
        for (int b = w; b < 10; b += 8) { const int i = b >= 6 ? 3 : (b >= 3 ? 2 : (b >= 1 ? 1 : 0)), j = b - i * (i + 1) / 2, base = (i * (i + 1) / 2) * 16;
            f32x4 acc = (f32x4){0.f, 0.f, 0.f, 0.f}; acc = mma_nt(QS + 16 * i * 136, 136, KS + (base + 16 * j) * 136, 136, 4, acc, lane);
#pragma unroll
            for (int rg = 0; rg < 4; ++rg) { const int tr = 4 * (lane >> 4) + rg, sccol = lane & 15; const float v = (j < i || sccol <= tr) ? acc[rg] : 0.f; P[(16 * i + tr) * 72 + 16 * j + sccol] = (bf16)f2bf(v); } }
        __syncthreads();
#pragma unroll
        for (int i = 0; i < 16; ++i) QS[(16 * sc + i) * 136 + k] = (bf16)f2bf(q[i] * fexp(cs[i] + off));
        { LAS bf16* ST = KS; const int kk = tid >> 2, vq = tid & 3; const float* sp = US + (size_t)unit * 16384 + (size_t)kk * 128 + vq * 32;
#pragma unroll
            for (int j = 0; j < 8; ++j) { const f32x4 s = *(const GAS f32x4*)(sp + 4 * j);
#pragma unroll
                for (int e = 0; e < 4; ++e) ST[(vq * 32 + 4 * j + e) * 136 + kk] = (bf16)f2bf(s[e]); } }
        __syncthreads();
        { const LAS bf16* ST = KS; const int tb = w >> 1, vb0 = 4 * (w & 1);
#pragma unroll
            for (int vb = 0; vb < 4; ++vb) { f32x4 acc = (f32x4){0.f, 0.f, 0.f, 0.f};
                acc = mma_nt(QS + 16 * tb * 136, 136, ST + 16 * (vb0 + vb) * 136, 136, 4, acc, lane);
                acc = mma_nt(P + 16 * tb * 72, 72, VT + 16 * (vb0 + vb) * 72, 72, 2, acc, lane);
#pragma unroll
                for (int rg = 0; rg < 4; ++rg) OB[(16 * tb + 4 * (lane >> 4) + rg) * 128 + 16 * (vb0 + vb) + (lane & 15)] = acc[rg]; } }
        __syncthreads();
        for (int i = 0; i < 8; ++i) { const int t = 8 * w + i, r = hg_row(n, t); if (r < 0) continue;
            const f32x2 o = *(const LAS f32x2*)(OB + t * 128 + 2 * lane); const float ss = wave_sum(o.x * o.x + o.y * o.y); const float rstd = 1.0f / sqrtf(ss * (1.f / 128.f) + NORM_EPS);
            const f32x2 gt = *(const GAS f32x2*)(GT + (size_t)r * 2048 + hh * 128 + 2 * lane), gw2 = *(const GAS f32x2*)(gnw + 2 * lane);
            *(GAS unsigned*)(MIX + (size_t)r * DM + hh * 128 + 2 * lane) = pk2(o.x * rstd * gw2.x * gt.x, o.y * rstd * gw2.y * gt.y); }
        __syncthreads();
    }
}
__device__ __forceinline__ void attn_phase(const Frame& F, const bf16* QB, const bf16* KB, const bf16* VB, const float* sinks, bf16* MIX) {
    LAS bf16* KL = (LAS bf16*)(F.lds + 0);
    LAS bf16* VT = (LAS bf16*)(F.lds + 41472);
    const int tid = F.tid, lane = F.lane, w = F.wave, g = lane >> 4, ql = lane & 15;
    for (int unit = F.vcu; unit < 260; unit += F.G) {
        const bool meta = unit >= 256; const int kvh = meta ? unit - 256 : unit >> 6, jb = meta ? 0 : unit & 63;
        for (int pass = 0; pass < 5; ++pass) { const int key = pass * 64 + (tid >> 3), d8 = (tid & 7) * 8; if (key >= 288) break;
            int r = -1;
            if (key < 128) r = (!meta && jb >= 1) ? 128 * (jb - 1) + key : -1; else if (key < 256) r = !meta ? 128 * jb + key - 128 : -1; else if (key < 272) r = SEQ + key - 256;
            v4u kk = (v4u){0u, 0u, 0u, 0u}, vv = kk;
            if (r >= 0) { kk = *(const GAS v4u*)(KB + (size_t)r * 256 + kvh * 64 + d8); vv = *(const GAS v4u*)(VB + (size_t)r * 256 + kvh * 64 + d8); }
            *(LAS v4u*)(KL + key * 72 + d8) = kk;
            const unsigned wv[4] = {vv.x, vv.y, vv.z, vv.w};
#pragma unroll
            for (int j = 0; j < 4; ++j) { VT[(d8 + 2 * j) * 296 + key] = (bf16)(wv[j] & 0xffffu); VT[(d8 + 2 * j + 1) * 296 + key] = (bf16)(wv[j] >> 16); } }
        __syncthreads();
        if (!meta || w == 0) {
            const int qi = meta ? ql : 16 * w + ql; const int qrow = meta ? SEQ + ql : 128 * jb + qi;
            for (int g8 = 0; g8 < 8; ++g8) { const int head = kvh * 8 + g8;
                const GAS bf16x8* qp = (const GAS bf16x8*)(QB + (size_t)qrow * 2048 + head * 64 + 8 * g);
                const bf16x8 q0 = qp[0], q1 = qp[4];
                f32x4 s[18]; const float sk = sinks[head]; float mx = sk;
#pragma unroll
                for (int kb = 0; kb < 18; ++kb) { f32x4 acc = (f32x4){0.f, 0.f, 0.f, 0.f}; const LAS bf16* kp = KL + (16 * kb + ql) * 72 + 8 * g;
                    acc = __builtin_amdgcn_mfma_f32_16x16x32_bf16(*(const LAS bf16x8*)kp, q0, acc, 0, 0, 0); acc = __builtin_amdgcn_mfma_f32_16x16x32_bf16(*(const LAS bf16x8*)(kp + 32), q1, acc, 0, 0, 0);
#pragma unroll
                    for (int rg = 0; rg < 4; ++rg) { const int kk = 16 * kb + 4 * g + rg; bool ok;
                        if (meta) ok = kk >= 256 && kk < 272 && (kk - 256) <= qi; else ok = kk < 128 ? (jb >= 1 && kk >= qi + 1) : (kk < 256 ? (kk - 128 <= qi) : kk < 272);
                        acc[rg] = ok ? acc[rg] * 0.125f : -1e30f; mx = fmaxf(mx, acc[rg]); }
                    s[kb] = acc; if (kb & 1) __builtin_amdgcn_sched_barrier(0); }
                mx = fmaxf(mx, __shfl_xor(mx, 16)); mx = fmaxf(mx, __shfl_xor(mx, 32));
                float l = 0.f; bf16x8 pf[9];
#pragma unroll
                for (int pp = 0; pp < 9; ++pp) { float e[8];
#pragma unroll
                    for (int rg = 0; rg < 4; ++rg) { e[rg] = fexp(s[2 * pp][rg] - mx); e[4 + rg] = fexp(s[2 * pp + 1][rg] - mx); }
#pragma unroll
                    for (int j = 0; j < 8; ++j) l += e[j];
                    const v4u pw = (v4u){pk2(e[0], e[1]), pk2(e[2], e[3]), pk2(e[4], e[5]), pk2(e[6], e[7])}; pf[pp] = __builtin_bit_cast(bf16x8, pw); }
                l += __shfl_xor(l, 16); l += __shfl_xor(l, 32); l += fexp(sk - mx);
                const float inv = 1.0f / l;
#pragma unroll 1
                for (int db = 0; db < 4; ++db) { f32x4 acc = (f32x4){0.f, 0.f, 0.f, 0.f}; const LAS bf16* vp = VT + (16 * db + ql) * 296 + 4 * g;
#pragma unroll
                    for (int pp = 0; pp < 9; ++pp) { const v2u lo = *(const LAS v2u*)(vp + 32 * pp), hi = *(const LAS v2u*)(vp + 32 * pp + 16); const v4u av = (v4u){lo.x, lo.y, hi.x, hi.y};
                        acc = __builtin_amdgcn_mfma_f32_16x16x32_bf16(__builtin_bit_cast(bf16x8, av), pf[pp], acc, 0, 0, 0); }
                    v2u o; o.x = pk2(acc[0] * inv, acc[1] * inv); o.y = pk2(acc[2] * inv, acc[3] * inv);
                    *(GAS v2u*)(MIX + (size_t)qrow * DM + 2048 + head * 64 + 16 * db + 4 * g) = o; }
            }
        }
        __syncthreads();
    }
}
template <int NB, class Epi>
__device__ __forceinline__ void skinny_gemm(const Frame& F, const bf16* A, int lda, const bf16* Bt, int ldb, int K, int nitems, int ipb, int pstride, int ashift, const Epi& epi) {
    LAS float* RED = (LAS float*)(F.lds + 0);
    LAS float* FIN = (LAS float*)(F.lds + 8 * NB * 1024);
    const int lane = F.lane, w = F.wave, g = lane >> 4, ql = lane & 15, kw = K >> 3, nks = kw >> 5;
    for (int item = F.vcu; item < nitems; item += F.G) {
        const int brow = (item / ipb) * pstride + (item % ipb) * 16;
        const int acol = ashift >= 0 ? (((item / ipb) >> ashift) << 8) : 0;
        const GAS bf16x8* ap = (const GAS bf16x8*)(A + (size_t)ql * lda + acol + w * kw + 8 * g);
        const GAS bf16x8* bp0 = (const GAS bf16x8*)(Bt + (size_t)(brow + ql) * ldb + w * kw + 8 * g);
        const GAS bf16x8* bp1 = (const GAS bf16x8*)(Bt + (size_t)(brow + 128 + ql) * ldb + w * kw + 8 * g);
        f32x4 acc0 = (f32x4){0.f, 0.f, 0.f, 0.f}, acc1 = acc0;
#pragma unroll 8
        for (int s = 0; s < nks; ++s) { const bf16x8 a = ap[4 * s], b0 = bp0[4 * s];
            acc0 = __builtin_amdgcn_mfma_f32_16x16x32_bf16(b0, a, acc0, 0, 0, 0);
            if (NB == 2) { const bf16x8 b1 = bp1[4 * s]; acc1 = __builtin_amdgcn_mfma_f32_16x16x32_bf16(b1, a, acc1, 0, 0, 0); } }
#pragma unroll
        for (int rg = 0; rg < 4; ++rg) { RED[((w * NB + 0) * 16 + 4 * g + rg) * 16 + ql] = acc0[rg]; if (NB == 2) RED[((w * NB + 1) * 16 + 4 * g + rg) * 16 + ql] = acc1[rg]; }
        __syncthreads();
        if (F.tid < 256 * NB) { const int b = F.tid >> 8, e = F.tid & 255; float s = 0.f;
#pragma unroll
            for (int ww = 0; ww < 8; ++ww) s += RED[(ww * NB + b) * 256 + e];
            FIN[b * 256 + e] = s; }
        __syncthreads();
        if (F.tid < 256) epi(item, F.tid >> 4, F.tid & 15, FIN);
        __syncthreads();
    }
}
#ifndef MK_SINGLE
#define MK_SINGLE 1
#endif
constexpr int N_PHASES = 22;
#ifndef PHMASK
#define PHMASK 0xffffffu
#endif
#define EN(k) (((PHMASK) >> ((k) % 24)) & 1u)
#define IN(k) (EN(k) && lo <= (k) && (k) < hi)
#define SEAM(k) do { if (IN(k) && IN((k) + 1)) xcd_barrier(bar); } while (0)
template <int L> __device__ __forceinline__ void layer_tail(Frame& F, const XcdBarrier& bar, int lo, int hi, const bf16* mixA) {
    constexpr int pb = (L == 0) ? 5 : 16;
    unsigned char* ws = F.ws; bf16* XN = (bf16*)(ws + WS_XN); float* H = (float*)(ws + WS_H); float* Y = (float*)(ws + WS_Y); unsigned char* ar = ws + WS_AR; const float* nw = F.in[2];
        if (IN(pb)) {
            pg8::Gemm g{mixA, (const bf16*)(ws + (L == 0 ? WS_WOUT_E : WS_WOUT_O)), SEQ, DM, DM, DM, DM, -1}; pg8::StaticOrder S; S.init(SEQ, DM, F.G, (int)blockIdx.x);
            pg8::EpiF32 E{Y, DM};
            pg8::gemm_phase<pg8::EpiF32, pg8::StaticOrder, true, true>(F.lds + RING_OFF, g, S, E);
            skinny_gemm<1>(F, g.A + (size_t)SEQ * g.lda, g.lda, g.Bt, g.ldb, g.K, DM / 16, 1, 16, -1, [=](int item, int n, int m, const LAS float* fin) { Y[(size_t)(SEQ + m) * DM + item * 16 + n] = fin[n * 16 + m]; });
        } SEAM(pb);
        if (IN(pb + 1)) { norm_pass(F, Y, L == 0, H, nw + (size_t)(L * 4 + 1) * DM, nw + (size_t)(L * 4 + 2) * DM, H, XN, 0); } SEAM(pb + 1);
        if (IN(pb + 2)) {
            pg8::Gemm g{XN, (const bf16*)(ws + WS_WGU + (size_t)L * SZ_WGU), SEQ, 2 * DFF, DM, DM, DM, -1}; pg8::StaticOrder S; S.init(SEQ, 2 * DFF, F.G, (int)blockIdx.x);
            pg8::EpiGU E{(float*)(ar + AR_G), (bf16*)(ar + AR_U)};
            pg8::gemm_phase<pg8::EpiGU, pg8::StaticOrder, true, true>(F.lds + RING_OFF, g, S, E);
            { float* Gp = (float*)(ar + AR_G); bf16* Up = (bf16*)(ar + AR_U);
              skinny_gemm<1>(F, XN + (size_t)SEQ * DM, DM, g.Bt, DM, DM, 2 * DFF / 16, 1, 16, -1, [=](int item, int n, int m, const LAS float* fin) {
                const float v = fin[n * 16 + m]; const int nb = item * 16 + n, p = nb >> 8, wi = nb & 255, ch = p * 128 + (wi & 127); const size_t o = (size_t)(SEQ + m) * DFF + ch;
                if (wi < 128) Gp[o] = v; else Up[o] = (bf16)f2bf(v); }); }
        } SEAM(pb + 2);
        if (IN(pb + 3)) { ffn_act_pass(F, (const float*)(ar + AR_G), (const bf16*)(ar + AR_U), F.in[18] + (size_t)L * 3 * DFF, F.in[19] + (size_t)L * DFF, (bf16*)(ar + AR_ACT)); } SEAM(pb + 3);
        if (IN(pb + 4)) {
            pg8::Gemm g{(const bf16*)(ar + AR_ACT), (const bf16*)(ws + WS_WD + (size_t)L * SZ_WD), SEQ, DM, DFF, DFF, DFF, -1}; pg8::StaticOrder S; S.init(SEQ, DM, F.G, (int)blockIdx.x);
            pg8::EpiF32 E{Y, DM};
            pg8::gemm_phase<pg8::EpiF32, pg8::StaticOrder, true, true>(F.lds + RING_OFF, g, S, E);
            skinny_gemm<1>(F, g.A + (size_t)SEQ * g.lda, g.lda, g.Bt, g.ldb, g.K, DM / 16, 1, 16, -1, [=](int item, int n, int m, const LAS float* fin) { Y[(size_t)(SEQ + m) * DM + item * 16 + n] = fin[n * 16 + m]; });
        } SEAM(pb + 4);
        if (IN(pb + 5)) {
            if (L == 0) norm_pass(F, Y, 0, H, nw + (size_t)3 * DM, nw + (size_t)4 * DM, H, XN, 0);
            else norm_pass(F, Y, 0, H, nw + (size_t)7 * DM, nullptr, F.out, nullptr, 1);
        }
        if (L == 0) SEAM(pb + 5);
}
struct Args { const float* in[21]; float* out; unsigned char* ws; int ph_lo, ph_hi; };
__global__ void __launch_bounds__(NWAVES * 64, 2) fwd_kernel(Args args) {
    extern __shared__ __attribute__((aligned(16))) unsigned char lds[];
    Frame F;
    F.lds = (LAS unsigned char*)lds;
    F.MISC = (volatile LAS unsigned*)(F.lds + MISC_OFF);
    F.tid = threadIdx.x; F.lane = F.tid & 63; F.wave = __builtin_amdgcn_readfirstlane(F.tid >> 6);
    F.G = gridDim.x; { const int bx = blockIdx.x; F.vcu = (F.G % 8 == 0) ? (bx % 8) * (F.G / 8) + bx / 8 : bx; }
    unsigned char* ws = args.ws; F.ws = ws;
    F.ctl = (gu32*)(ws + WS_CTL);
#pragma unroll
    for (int i = 0; i < 21; ++i) F.in[i] = args.in[i];
    F.out = args.out;
    for (int u = F.tid; u < (LDS_BYTES - LDSCTL_OFF) / 4; u += NWAVES * 64) ((LAS unsigned*)(F.lds + LDSCTL_OFF))[u] = 0u;
    __syncthreads();
    const int lo = args.ph_lo, hi = args.ph_hi;
    XcdBarrier bar; bar.bar = (unsigned*)(F.ctl + CW_BAR); bar.x = 0; bar.st = nullptr;
    if (hi - lo > 1) bar = xcd_barrier_post((unsigned*)(F.ctl + CW_BAR), F.MISC + 8);
    bf16* XN = (bf16*)(ws + WS_XN); float* H = (float*)(ws + WS_H); float* Y = (float*)(ws + WS_Y); unsigned char* ar = ws + WS_AR;
    const float* nw = F.in[2];

    if (IN(0)) { p0_prologue(F); } SEAM(0);

    {
        const bf16* mixA;
        {
            mixA = (const bf16*)(ar + AR_MIX);
            if (IN(1)) {
                pg8::Gemm g{XN, (const bf16*)(ws + WS_WIN_E), SEQ, EVEN_IN, DM, DM, DM, -1}; pg8::StaticOrder S; S.init(SEQ, EVEN_IN, F.G, (int)blockIdx.x);
                pg8::EpiInEven E{(float*)(ar + AR_QA), (float*)(ar + AR_GL), (float*)(ar + AR_GT), (bf16*)(ar + AR_VA), (bf16*)(ar + AR_QB), (bf16*)(ar + AR_KB), (bf16*)(ar + AR_VB), F.in[4]};
                pg8::gemm_phase<pg8::EpiInEven, pg8::StaticOrder, true, true>(F.lds + RING_OFF, g, S, E);
                { float* QA = (float*)(ar + AR_QA); float* GL = (float*)(ar + AR_GL); float* GT = (float*)(ar + AR_GT); bf16* VA = (bf16*)(ar + AR_VA); bf16* QB = (bf16*)(ar + AR_QB); bf16* KB = (bf16*)(ar + AR_KB); bf16* VB = (bf16*)(ar + AR_VB); const float* lbl = F.in[4];
                  skinny_gemm<1>(F, XN + (size_t)SEQ * DM, DM, (const bf16*)(ws + WS_WIN_E), DM, DM, EVEN_IN / 16, 1, 16, -1, [=](int item, int n, int m, const LAS float* fin) {
                    const float v = fin[n * 16 + m]; const int col = item * 16 + n; const size_t r = (size_t)(SEQ + m); const int seg = col >> 11, c = col & 2047;
                    if (seg == 0) QA[r * 2048 + c] = fsilu(v);
                    else if (seg == 1) { const float lb = frcp(1.0f + fexp(lbl[2048 + c] - lbl[c])); GL[r * 2048 + c] = __logf(lb + (1.0f - lb) * fsigmoid(v)); }
                    else if (seg == 2) VA[r * 2048 + c] = (bf16)f2bf(v);
                    else if (seg == 3) GT[r * 2048 + c] = fsilu(v);
                    else if (seg == 4) QB[r * 2048 + c] = (bf16)f2bf(v);
                    else if (c < 256) KB[r * 256 + c] = (bf16)f2bf(v);
                    else VB[r * 256 + c - 256] = (bf16)f2bf(v); }); }
            } SEAM(1);
            if (IN(2)) {
                attn_phase(F, (const bf16*)(ar + AR_QB), (const bf16*)(ar + AR_KB), (const bf16*)(ar + AR_VB), F.in[6], (bf16*)(ar + AR_MIX));
                hgrn_h1(F, (const float*)(ar + AR_GL), (const bf16*)(ar + AR_VA), (float*)(ar + AR_US), (float*)(ar + AR_DS));
            } SEAM(2);
            if (IN(3)) { hgrn_h2(F, (float*)(ar + AR_US), (const float*)(ar + AR_DS)); } SEAM(3);
            if (IN(4)) { hgrn_h3(F, (const float*)(ar + AR_QA), (const float*)(ar + AR_GL), (const float*)(ar + AR_GT), (const bf16*)(ar + AR_VA), (const float*)(ar + AR_US), F.in[5], (bf16*)(ar + AR_MIX)); } SEAM(4);
        }
        layer_tail<0>(F, bar, lo, hi, mixA);
        {
            mixA = (const bf16*)(ar + AR_LO);
            if (IN(11)) {
                pg8::Gemm g{XN, (const bf16*)(ws + WS_WIN_O), SEQ, 8192, DM, DM, DM, -1}; pg8::StaticOrder S; S.init(SEQ, 8192, F.G, (int)blockIdx.x);
                pg8::EpiInOdd E{(bf16*)(ar + AR_YBR), (float*)(ar + AR_XBR)};
                pg8::gemm_phase<pg8::EpiInOdd, pg8::StaticOrder, true, true>(F.lds + RING_OFF, g, S, E);
                { bf16* YB = (bf16*)(ar + AR_YBR); float* XB = (float*)(ar + AR_XBR);
                  skinny_gemm<1>(F, XN + (size_t)SEQ * DM, DM, (const bf16*)(ws + WS_WIN_O), DM, DM, 8192 / 16, 1, 16, -1, [=](int item, int n, int m, const LAS float* fin) {
                    const float v = fin[n * 16 + m]; const int col = item * 16 + n; const size_t r = (size_t)(SEQ + m);
                    if (col < DM) YB[r * DM + col] = (bf16)f2bf(fgelu_tanh(v)); else XB[r * DM + col - DM] = v; }); }
            } SEAM(11);
            if (IN(12)) { lru_conv_pass(F, (const float*)(ar + AR_XBR), F.in[9], F.in[10], (float*)(ar + AR_XC), (bf16*)(ar + AR_XCB)); } SEAM(12);
            if (IN(13)) {
                pg8::Gemm g{(const bf16*)(ar + AR_XCB), (const bf16*)(ws + WS_WG), SEQ, 8192, 256, DM, 256, 1}; pg8::StaticOrder S; S.init(SEQ, 8192, F.G, (int)blockIdx.x);
                pg8::EpiGates E{(const float*)(ar + AR_XC), F.in[12], F.in[14], (const float*)(ws + WS_LS8), (float*)(ar + AR_A), (float*)(ar + AR_BI)};
                pg8::gemm_phase<pg8::EpiGates, pg8::StaticOrder, true, true>(F.lds + RING_OFF, g, S, E);
                { const float* XC = (const float*)(ar + AR_XC); const float* ba = F.in[12]; const float* bx = F.in[14]; const float* ls8 = (const float*)(ws + WS_LS8); float* Ao = (float*)(ar + AR_A); float* Bo = (float*)(ar + AR_BI);
                  skinny_gemm<2>(F, (const bf16*)(ar + AR_XCB) + (size_t)SEQ * DM, DM, (const bf16*)(ws + WS_WG), 256, 256, 32 * 8, 8, 256, 1, [=](int item, int n, int m, const LAS float* fin) {
                    const int p = item >> 3, j = item & 7, ch = (p >> 1) * 256 + (p & 1) * 128 + 16 * j + n; const size_t o = (size_t)(SEQ + m) * DM + ch;
                    const float ga = fin[n * 16 + m], gx = fin[256 + n * 16 + m];
                    const float la = ls8[ch] * fsigmoid(ga + ba[ch]); const float t = 2.0f * la;
                    const float ser = t * (1.0f + 0.5f * t * (1.0f + (1.0f / 3.0f) * t * (1.0f + 0.25f * t * (1.0f + 0.2f * t * (1.0f + (1.0f / 6.0f) * t)))));
                    const float em1 = t > -0.25f ? ser : fexp(t) - 1.0f;
                    Ao[o] = fexp(la); Bo[o] = __builtin_sqrtf(-em1) * (fsigmoid(gx + bx[ch]) * XC[o]); }); }
            } SEAM(13);
            if (IN(14)) { lru_scan1(F, (const float*)(ar + AR_A), (const float*)(ar + AR_BI), (float*)(ar + AR_CA), (float*)(ar + AR_CB)); } SEAM(14);
            if (IN(15)) { lru_scan2(F, (const float*)(ar + AR_A), (const float*)(ar + AR_BI), (const float*)(ar + AR_CA), (const float*)(ar + AR_CB), (const bf16*)(ar + AR_YBR), (bf16*)(ar + AR_LO)); } SEAM(15);
        }
        layer_tail<1>(F, bar, lo, hi, mixA);
    }
}

#ifndef DBG_STOP
#define DBG_STOP -1
#endif
__global__ void dbg_copy_h(const float4* __restrict__ h, float4* __restrict__ o, size_t n4) { for (size_t i = (size_t)blockIdx.x * blockDim.x + threadIdx.x; i < n4; i += (size_t)gridDim.x * blockDim.x) o[i] = h[i]; }
extern "C" void kernel_launch(void* const* d_in, const int* in_sizes, int n_in, void* d_out, int out_size, void* d_ws, size_t ws_size, hipStream_t stream) {
    static int grid = 0;
    if (grid == 0) {
        if (n_in != 21 || out_size != SEQ * DM || ws_size < WS_END) { fprintf(stderr, "kernel_launch: unexpected problem (n_in %d out %d ws %zu need %zu)\n", n_in, out_size, ws_size, (size_t)WS_END); grid = -1; return; }
        int dev = 0, cus = 0, per_cu = 0;
        if (hipGetDevice(&dev) != hipSuccess || hipDeviceGetAttribute(&cus, hipDeviceAttributeMultiprocessorCount, dev) != hipSuccess) { grid = -1; return; }
        if (hipFuncSetAttribute((const void*)fwd_kernel, hipFuncAttributeMaxDynamicSharedMemorySize, LDS_BYTES) != hipSuccess) { fprintf(stderr, "kernel_launch: hipFuncSetAttribute failed\n"); grid = -1; return; }
        if (hipOccupancyMaxActiveBlocksPerMultiprocessor(&per_cu, (const void*)fwd_kernel, NWAVES * 64, LDS_BYTES) != hipSuccess || per_cu < 1) fprintf(stderr, "kernel_launch: occupancy query says %d\n", per_cu);
        (void)hipGetLastError();
        grid = cus;
    }
    if (grid < 0) return;
    (void)hipMemsetAsync((char*)d_ws + WS_CTL, 0, CTL_ZERO_BYTES, stream);
    Args a{};
    for (int i = 0; i < 21; ++i) a.in[i] = (const float*)d_in[i];
    a.out = (float*)d_out; a.ws = (unsigned char*)d_ws;
#if MK_SINGLE
    a.ph_lo = 0; a.ph_hi = N_PHASES;
    hipLaunchKernelGGL(fwd_kernel, dim3(grid), dim3(NWAVES * 64), LDS_BYTES, stream, a);
#else
    const int last = (DBG_STOP >= 0) ? DBG_STOP : N_PHASES - 1;
#ifndef REPMASK
#define REPMASK 0u
#endif
    for (int k = 0; k <= last; ++k) { a.ph_lo = k; a.ph_hi = k + 1; const int nrep = ((REPMASK >> k) & 1u) ? 2 : 1;
        for (int rep = 0; rep < nrep; ++rep) hipLaunchKernelGGL(fwd_kernel, dim3(grid), dim3(NWAVES * 64), LDS_BYTES, stream, a); }
    if (DBG_STOP >= 0) hipLaunchKernelGGL(dbg_copy_h, dim3(2048), dim3(256), 0, stream, (const float4*)((const char*)d_ws + WS_H), (float4*)d_out, (size_t)SEQ * DM / 4);
#endif
}
```

```cpp
#include <hip/hip_runtime.h>
#include <cstdio>
#include <cstdint>

#define GAS __attribute__((address_space(1)))
#define LAS __attribute__((address_space(3)))
typedef unsigned short bf16;
typedef unsigned v4u __attribute__((ext_vector_type(4)));
typedef unsigned v2u __attribute__((ext_vector_type(2)));
typedef float f32x4 __attribute__((ext_vector_type(4)));
typedef float f32x2 __attribute__((ext_vector_type(2)));
typedef short bf16x8 __attribute__((ext_vector_type(8)));
typedef short bf16x4 __attribute__((ext_vector_type(4)));
typedef GAS unsigned gu32;

constexpr int DM = 4096, SEQ = 8192, NMETA = 16, LTOK = SEQ + NMETA;
constexpr int MP = 8448;
constexpr int NPAN = MP / 256;
constexpr int A_HEADS = 16, A_K = 128, A_V = 128, A_F = 2048;
constexpr int B_HD = 64, B_QH = 32, B_KVH = 4, B_GRP = 8, B_W = 2048, B_KVW = 256;
constexpr int EVEN_IN = 10752, DFF = 11008, LRU_W = 4096;
constexpr int NCHUNK = 129;
constexpr float NORM_EPS = 1e-6f;

constexpr size_t MiB = 1u << 20;
constexpr size_t WS_CTL = 0, CTL_ZERO_BYTES = 1 * MiB;
constexpr size_t SZ_WIN_E = (size_t)EVEN_IN * DM * 2, SZ_W44 = (size_t)DM * DM * 2, SZ_WIN_O = (size_t)8192 * DM * 2, SZ_WG = (size_t)8192 * 256 * 2,
                 SZ_WGU = (size_t)2 * DFF * DM * 2, SZ_WD = (size_t)DM * DFF * 2;
constexpr size_t WS_WIN_E = 1 * MiB;
constexpr size_t WS_WOUT_E = WS_WIN_E + SZ_WIN_E;
constexpr size_t WS_WIN_O = WS_WOUT_E + SZ_W44;
constexpr size_t WS_WG = WS_WIN_O + SZ_WIN_O;
constexpr size_t WS_WOUT_O = WS_WG + SZ_WG;
constexpr size_t WS_WGU = WS_WOUT_O + SZ_W44;
constexpr size_t WS_WD = WS_WGU + 2 * SZ_WGU;
constexpr size_t WS_H = WS_WD + 2 * SZ_WD;
constexpr size_t SZ_F32ROW = (size_t)MP * DM * 4, SZ_BFROW = (size_t)MP * DM * 2;
constexpr size_t WS_XN = WS_H + SZ_F32ROW;
constexpr size_t WS_Y = WS_XN + SZ_BFROW;
constexpr size_t WS_AR = WS_Y + SZ_F32ROW;
constexpr size_t AR_QA = 0;
constexpr size_t AR_GL = AR_QA + (size_t)MP * 2048 * 4;
constexpr size_t AR_GT = AR_GL + (size_t)MP * 2048 * 4;
constexpr size_t AR_VA = AR_GT + (size_t)MP * 2048 * 4;
constexpr size_t AR_QB = AR_VA + (size_t)MP * 2048 * 2;
constexpr size_t AR_KB = AR_QB + (size_t)MP * 2048 * 2;
constexpr size_t AR_VB = AR_KB + (size_t)MP * 256 * 2;
constexpr size_t AR_US = AR_VB + (size_t)MP * 256 * 2;
constexpr size_t AR_DS = AR_US + (size_t)A_HEADS * NCHUNK * 16384 * 4;
constexpr size_t AR_SS = AR_DS + (size_t)A_HEADS * NCHUNK * 128 * 4;
constexpr size_t AR_MIX = AR_SS + (size_t)A_HEADS * NCHUNK * 16384 * 2;
constexpr size_t AR_L0_END = AR_MIX + SZ_BFROW;
constexpr size_t AR_HG = 0;
constexpr size_t AR_HU = AR_HG + (size_t)129 * 4 * DFF * 4;
constexpr size_t AR_ACT = AR_HU + (size_t)129 * 2 * DFF * 4;
constexpr size_t AR_FFN_END = AR_ACT + (size_t)MP * DFF * 2;
constexpr size_t AR_YBR = 0;
constexpr size_t AR_XBR = AR_YBR + SZ_BFROW;
constexpr size_t AR_XC = AR_XBR + SZ_F32ROW;
constexpr size_t AR_XCB = AR_XC + SZ_F32ROW;
constexpr size_t AR_AB = AR_XCB + SZ_BFROW;
constexpr size_t AR_CA = AR_AB + SZ_F32ROW;
constexpr size_t AR_CB = AR_CA + (size_t)NCHUNK * DM * 4;
constexpr size_t AR_LO = AR_CB + (size_t)NCHUNK * DM * 4;
constexpr size_t AR_L1_END = AR_LO + SZ_BFROW;
constexpr size_t AR_SIZE = (AR_FFN_END > AR_L0_END ? (AR_FFN_END > AR_L1_END ? AR_FFN_END : AR_L1_END) : (AR_L0_END > AR_L1_END ? AR_L0_END : AR_L1_END));
constexpr size_t WS_END = WS_AR + AR_SIZE;

constexpr size_t WS_LS8 = 512 * 1024;
constexpr int CW_TMO = 0, CW_CODE = 1;
constexpr int CW_BAR = 4096;

constexpr int RING_OFF = 0, RING_BYTES = 131072;
constexpr int LDSCTL_OFF = RING_BYTES, MISC_OFF = LDSCTL_OFF + 320;
constexpr int LDS_BYTES = 147456;
constexpr int NWAVES = 8;

#define RLX_AGENT __ATOMIC_RELAXED, __HIP_MEMORY_SCOPE_AGENT
#define LDS_WAIT() asm volatile("s_waitcnt lgkmcnt(0)" ::: "memory")
#define VM_WAIT() asm volatile("s_waitcnt vmcnt(0)" ::: "memory")
__device__ __forceinline__ unsigned f2bf(float f) { unsigned u = __builtin_bit_cast(unsigned, f); return (u + 0x7fffu + ((u >> 16) & 1u)) >> 16; }
__device__ __forceinline__ unsigned pk2(float lo, float hi) { return f2bf(lo) | (f2bf(hi) << 16); }
__device__ __forceinline__ float bflo(unsigned w) { return __builtin_bit_cast(float, w << 16); }
__device__ __forceinline__ float bfhi(unsigned w) { return __builtin_bit_cast(float, w & 0xffff0000u); }
__device__ __forceinline__ float bf1(bf16 h) { return __builtin_bit_cast(float, ((unsigned)h) << 16); }
__device__ __forceinline__ float fexp(float x) { return __builtin_amdgcn_exp2f(x * 1.4426950408889634f); }
__device__ __forceinline__ float frcp(float x) { return __builtin_amdgcn_rcpf(x); }
__device__ __forceinline__ float fsigmoid(float x) { return frcp(1.0f + fexp(-x)); }
__device__ __forceinline__ float fsilu(float x) { return x * fsigmoid(x); }
__device__ __forceinline__ float fgelu_tanh(float x) { const float t = 0.7978845608028654f * (x + 0.044715f * x * x * x); return x * frcp(1.0f + fexp(-2.0f * t)); }
__device__ __forceinline__ float wave_sum(float v) {
#pragma unroll
    for (int o = 1; o < 64; o <<= 1) v += __shfl_xor(v, o);
    return v;
}
namespace pg8 {
#define PG8_LAS __attribute__((address_space(3)))
typedef unsigned short bf16_t;
typedef short bf16x8 __attribute__((ext_vector_type(8)));
typedef float f32x4 __attribute__((ext_vector_type(4)));
typedef unsigned u32x4 __attribute__((ext_vector_type(4)));
constexpr int BM = 256, BK = 64, HALF = 128, HTB = HALF * BK * 2  , STAGE_BYTES = 8 * HTB, NXCD = 8, WGM = 8;

__host__ __device__ __forceinline__ int lds_byte(int r, int c) { const int st = (r >> 4) * 2 + (c >> 5), rr = r & 15, cc = c & 31, ob = rr * 64 + cc * 2; return st * 1024 + (ob ^ (((ob >> 9) & 1) << 5)); }
__host__ __device__ __forceinline__ void stage_rc(int b, int& R, int& C) { const int st = b / 1024, sb = b % 1024, swz = sb ^ (((sb >> 9) & 1) << 5); R = (st >> 1) * 16 + swz / 64; C = (st & 1) * 32 + (swz % 64) / 2; }
__host__ __device__ __forceinline__ int perm32(int rho) { const int n = rho >> 4, i = rho & 15; return 8 * (i >> 2) + 4 * n + (i & 3); }

struct Unit { int pm, pn; };
struct Gemm { const bf16_t* A; const bf16_t* Bt; int M, N, K; int lda, ldb; int acol_shift; };

struct StaticOrder {
    int nM, nN, nwg, G, c;
    __host__ __device__ void init(int M, int N, int G_, int c_) { nM = M / BM; nN = N / BM; nwg = nM * nN; G = G_; c = c_; }
    __host__ __device__ bool next(int i, Unit& u) const {
        const long L = (long)i * G + c; if (L >= nwg) return false;
        int wgid = (int)L; { const int q = nwg / NXCD, r = nwg % NXCD, xcd = wgid % NXCD, off = wgid / NXCD; wgid = (xcd < r ? xcd * (q + 1) : r * (q + 1) + (xcd - r) * q) + off; }
        const int nig = WGM * nN, gid = wgid / nig, fm = gid * WGM, gsz = (nM - fm) < WGM ? (nM - fm) : WGM;
        u.pm = fm + ((wgid % nig) % gsz); u.pn = (wgid % nig) / gsz; return true;
    }
    __device__ __forceinline__ void a_ready(const Unit&) const {}
    __device__ __forceinline__ void done(const Unit&) const {}
};
__device__ __forceinline__ unsigned cvt_pk_bf16(float lo, float hi) { unsigned r; asm volatile("v_cvt_pk_bf16_f32 %0, %1, %2" : "=v"(r) : "v"(lo), "v"(hi)); return r; }
}
namespace pg8 {
__device__ __forceinline__ void st_f32x8(float* p, f32x4 a, f32x4 b) { *(f32x4*)p = a; *(f32x4*)(p + 4) = b; }
__device__ __forceinline__ void st_bf16x8(bf16_t* p, f32x4 a, f32x4 b) { u32x4 w; w.x = cvt_pk_bf16(a[0], a[1]); w.y = cvt_pk_bf16(a[2], a[3]); w.z = cvt_pk_bf16(b[0], b[1]); w.w = cvt_pk_bf16(b[2], b[3]); *(u32x4*)p = w; }

struct EpiF32 {
    static constexpr bool PERM = true, AFTER_DRAIN = false;
    float* C; int ldc;
    __device__ __forceinline__ void operator()(const f32x4 (&acc)[2][2][4][2], const Unit& u, int wr, int wc, int fr, int fq) const {
        const unsigned lo = (unsigned)((wr * 64 + fr) * ldc + wc * 32 + 8 * fq);
#pragma unroll
        for (int ai = 0; ai < 2; ++ai)
#pragma unroll
            for (int m = 0; m < 4; ++m) { float* rowp = C + (size_t)(u.pm * BM + ai * HALF + m * 16) * ldc + u.pn * BM;
#pragma unroll
                for (int bj = 0; bj < 2; ++bj) st_f32x8(rowp + lo + bj * HALF, acc[ai][bj][m][0], acc[ai][bj][m][1]); }
    }
};

struct EpiInEven {
    static constexpr bool PERM = true, AFTER_DRAIN = false;
    float* QA; float* GL; float* GT; bf16_t* VA; bf16_t* QB; bf16_t* KB; bf16_t* VB; const float* lbl;
    __device__ __forceinline__ void operator()(const f32x4 (&acc)[2][2][4][2], const Unit& u, int wr, int wc, int fr, int fq) const {
        const int seg = u.pn >> 3; const int cu = (u.pn & 7) * BM;
        const unsigned lc = (unsigned)(wc * 32 + 8 * fq);
        const unsigned lo = (unsigned)((wr * 64 + fr) * 2048) + lc;
        if (seg == 0 || seg == 3) {
            float* D = (seg == 0 ? QA : GT) + (size_t)(u.pm * BM) * 2048 + cu;
#pragma unroll
            for (int ai = 0; ai < 2; ++ai)
#pragma unroll
                for (int m = 0; m < 4; ++m) { float* rowp = D + (size_t)(ai * HALF + m * 16) * 2048;
#pragma unroll
                    for (int bj = 0; bj < 2; ++bj) { f32x4 a = acc[ai][bj][m][0], b = acc[ai][bj][m][1];
#pragma unroll
                        for (int j = 0; j < 4; ++j) { a[j] = fsilu(a[j]); b[j] = fsilu(b[j]); }
                        st_f32x8(rowp + lo + bj * HALF, a, b); } }
        } else if (seg == 1) {
            f32x4 lb[2][2];
#pragma unroll
            for (int bj = 0; bj < 2; ++bj)
#pragma unroll
                for (int n = 0; n < 2; ++n) { const f32x4 l0 = *(const f32x4*)(lbl + cu + lc + bj * HALF + 4 * n), l1 = *(const f32x4*)(lbl + 2048 + cu + lc + bj * HALF + 4 * n);
#pragma unroll
                    for (int j = 0; j < 4; ++j) lb[bj][n][j] = frcp(1.0f + fexp(l1[j] - l0[j])); }
            float* D = GL + (size_t)(u.pm * BM) * 2048 + cu;
#pragma unroll
            for (int ai = 0; ai < 2; ++ai)
#pragma unroll
                for (int m = 0; m < 4; ++m) { float* rowp = D + (size_t)(ai * HALF + m * 16) * 2048;
#pragma unroll
                    for (int bj = 0; bj < 2; ++bj) { f32x4 a = acc[ai][bj][m][0], b = acc[ai][bj][m][1];
#pragma unroll
                        for (int j = 0; j < 4; ++j) { a[j] = __logf(lb[bj][0][j] + (1.0f - lb[bj][0][j]) * fsigmoid(a[j])); b[j] = __logf(lb[bj][1][j] + (1.0f - lb[bj][1][j]) * fsigmoid(b[j])); }
                        st_f32x8(rowp + lo + bj * HALF, a, b); } }
        } else if (seg == 2 || seg == 4) {
            bf16_t* D = (seg == 2 ? VA : QB) + (size_t)(u.pm * BM) * 2048 + cu;
#pragma unroll
            for (int ai = 0; ai < 2; ++ai)
#pragma unroll
                for (int m = 0; m < 4; ++m) { bf16_t* rowp = D + (size_t)(ai * HALF + m * 16) * 2048;
#pragma unroll
                    for (int bj = 0; bj < 2; ++bj) st_bf16x8(rowp + lo + bj * HALF, acc[ai][bj][m][0], acc[ai][bj][m][1]); }
        } else {
            bf16_t* D = ((u.pn == 40) ? KB : VB) + (size_t)(u.pm * BM) * 256; const unsigned lo2 = (unsigned)((wr * 64 + fr) * 256) + lc;
#pragma unroll
            for (int ai = 0; ai < 2; ++ai)
#pragma unroll
                for (int m = 0; m < 4; ++m) { bf16_t* rowp = D + (size_t)(ai * HALF + m * 16) * 256;
#pragma unroll
                    for (int bj = 0; bj < 2; ++bj) st_bf16x8(rowp + lo2 + bj * HALF, acc[ai][bj][m][0], acc[ai][bj][m][1]); }
        }
    }
};

__device__ __forceinline__ float dpp_ror1(float x) { return __builtin_bit_cast(float, __builtin_amdgcn_update_dpp(0, __builtin_bit_cast(int, x), 0x121, 0xf, 0xf, false)); }
__device__ __forceinline__ float dpp_ror2(float x) { return __builtin_bit_cast(float, __builtin_amdgcn_update_dpp(0, __builtin_bit_cast(int, x), 0x122, 0xf, 0xf, false)); }
struct EpiGUAct {
    static constexpr bool PERM = true, AFTER_DRAIN = false;
    bf16_t* ACT; float* HG; float* HU; const float* cw; const float* cb;
    __device__ __forceinline__ void operator()(const f32x4 (&acc)[2][2][4][2], const Unit& u, int wr, int wc, int fr, int fq) const {
        const int chu = u.pn * HALF; const unsigned lc = (unsigned)(wc * 32 + 8 * fq);
#pragma unroll
        for (int ai = 0; ai < 2; ++ai) { const int strip = u.pm * 4 + ai * 2 + wr;
            if (fr < 2) { st_f32x8(HG + (size_t)(strip * 4 + fr) * DFF + chu + lc, acc[ai][0][0][0], acc[ai][0][0][1]); st_f32x8(HU + (size_t)(strip * 2 + fr) * DFF + chu + lc, acc[ai][1][0][0], acc[ai][1][0][1]); }
            if (fr >= 14) st_f32x8(HG + (size_t)(strip * 4 + 2 + fr - 14) * DFF + chu + lc, acc[ai][0][3][0], acc[ai][0][3][1]); }
        const bool f1 = fr >= 1, f2 = fr >= 2;
#pragma unroll
        for (int n = 0; n < 2; ++n) {
            const f32x4 w0 = *(const f32x4*)(cw + chu + lc + 4 * n), w1 = *(const f32x4*)(cw + DFF + chu + lc + 4 * n), w2 = *(const f32x4*)(cw + 2 * DFF + chu + lc + 4 * n), bb = *(const f32x4*)(cb + chu + lc + 4 * n);
#pragma unroll
            for (int ai = 0; ai < 2; ++ai) {
                f32x4 res[4];
#pragma unroll
                for (int j = 0; j < 4; ++j) {
                    float gm[4], r1[4], r2[4];
#pragma unroll
                    for (int m = 0; m < 4; ++m) { gm[m] = acc[ai][0][m][n][j]; r1[m] = dpp_ror1(gm[m]); r2[m] = dpp_ror2(gm[m]); }
#pragma unroll
                    for (int m = 0; m < 4; ++m) { const float q1 = m > 0 ? r1[m > 0 ? m - 1 : 0] : 0.f, q2 = m > 0 ? r2[m > 0 ? m - 1 : 0] : 0.f;
                        const float p1 = f1 ? r1[m] : q1, p2 = f2 ? r2[m] : q2;
                        const float v = bb[j] + w0[j] * p2 + w1[j] * p1 + w2[j] * gm[m];
                        res[m][j] = fgelu_tanh(v) * acc[ai][1][m][n][j]; }
                }
                bf16_t* rowp = ACT + (size_t)(u.pm * BM + ai * HALF + wr * 64) * DFF + chu + 4 * n;
#pragma unroll
                for (int m = 0; m < 4; ++m) { typedef unsigned u32x2 __attribute__((ext_vector_type(2))); u32x2 o; o.x = cvt_pk_bf16(res[m][0], res[m][1]); o.y = cvt_pk_bf16(res[m][2], res[m][3]);
                    if (m > 0 || f2) *(u32x2*)(rowp + (size_t)(16 * m + fr) * DFF + lc) = o; }
            }
        }
    }
};

struct EpiInOdd {
    static constexpr bool PERM = true, AFTER_DRAIN = false;
    bf16_t* Y; float* X;
    __device__ __forceinline__ void operator()(const f32x4 (&acc)[2][2][4][2], const Unit& u, int wr, int wc, int fr, int fq) const {
        const unsigned lo = (unsigned)((wr * 64 + fr) * DM + wc * 32 + 8 * fq);
        if (u.pn < 16) {
#pragma unroll
            for (int ai = 0; ai < 2; ++ai)
#pragma unroll
                for (int m = 0; m < 4; ++m) { bf16_t* rowp = Y + (size_t)(u.pm * BM + ai * HALF + m * 16) * DM + (u.pn & 15) * BM;
#pragma unroll
                    for (int bj = 0; bj < 2; ++bj) { f32x4 a = acc[ai][bj][m][0], b = acc[ai][bj][m][1];
#pragma unroll
                        for (int j = 0; j < 4; ++j) { a[j] = fgelu_tanh(a[j]); b[j] = fgelu_tanh(b[j]); }
                        st_bf16x8(rowp + lo + bj * HALF, a, b); } }
        } else {
#pragma unroll
            for (int ai = 0; ai < 2; ++ai)
#pragma unroll
                for (int m = 0; m < 4; ++m) { float* rowp = X + (size_t)(u.pm * BM + ai * HALF + m * 16) * DM + (u.pn & 15) * BM;
#pragma unroll
                    for (int bj = 0; bj < 2; ++bj) st_f32x8(rowp + lo + bj * HALF, acc[ai][bj][m][0], acc[ai][bj][m][1]); }
        }
    }
};

struct EpiGates {
    static constexpr bool PERM = true, AFTER_DRAIN = false;
    const float* XC; const float* ba; const float* bx; const float* ls8; unsigned* AB;
    __device__ __forceinline__ void operator()(const f32x4 (&acc)[2][2][4][2], const Unit& u, int wr, int wc, int fr, int fq) const {
        const int chu = (u.pn >> 1) * BM + (u.pn & 1) * HALF; const unsigned lc = (unsigned)(wc * 32 + 8 * fq), lo = (unsigned)((wr * 64 + fr) * DM) + lc;
        f32x4 vba[2], vbx[2], vls[2];
#pragma unroll
        for (int n = 0; n < 2; ++n) { vba[n] = *(const f32x4*)(ba + chu + lc + 4 * n); vbx[n] = *(const f32x4*)(bx + chu + lc + 4 * n); vls[n] = *(const f32x4*)(ls8 + chu + lc + 4 * n); }
#pragma unroll
        for (int ai = 0; ai < 2; ++ai)
#pragma unroll
            for (int m = 0; m < 4; ++m) { const size_t ro = (size_t)(u.pm * BM + ai * HALF + m * 16) * DM + chu;
#pragma unroll
                for (int n = 0; n < 2; ++n) {
                    const f32x4 x = *(const f32x4*)(XC + ro + lo + 4 * n); u32x4 ab;
#pragma unroll
                    for (int j = 0; j < 4; ++j) { const float la = vls[n][j] * fsigmoid(acc[ai][0][m][n][j] + vba[n][j]); const float t = 2.0f * la;
                        const float ser = t * (1.0f + 0.5f * t * (1.0f + (1.0f / 3.0f) * t * (1.0f + 0.25f * t * (1.0f + 0.2f * t * (1.0f + (1.0f / 6.0f) * t)))));
                        const float em1 = t > -0.25f ? ser : fexp(t) - 1.0f;
                        ab[j] = cvt_pk_bf16(la, __builtin_sqrtf(-em1) * (fsigmoid(acc[ai][1][m][n][j] + vbx[n][j]) * x[j])); }
                    *(u32x4*)(AB + ro + lo + 4 * n) = ab; }
                asm volatile("" ::: "memory"); }
    }
};
}
namespace pg8 {
template <class Epi, class Sched, bool ALIGN_EPI = false, bool SP2 = false>
__device__ __forceinline__ void gemm_phase(PG8_LAS unsigned char* lds, const Gemm g, const Sched& S, const Epi& E) {
    const int tid = threadIdx.x, wid = __builtin_amdgcn_readfirstlane(tid >> 6), lane = tid & 63, wr = wid >> 2, wc = wid & 3, fr = lane & 15, fq = lane >> 4;
    const int K = g.K, nt = K / BK;
    unsigned voffA[2], voffB[2];
#pragma unroll
    for (int i = 0; i < 2; ++i) { int R, C; stage_rc(tid * 16 + i * 8192, R, C); const int Rb = Epi::PERM ? ((R & ~31) + perm32(R & 31)) : R;
        voffA[i] = (unsigned)(R * g.lda + C) * 2u; voffB[i] = (unsigned)(Rb * g.ldb + C) * 2u; }
    const size_t kstep = (size_t)(BK * 2);
    const size_t hstepA = (size_t)HALF * g.lda * 2, hstepB = (size_t)HALF * g.ldb * 2;
    const size_t tstepA = 2 * hstepA, tstepB = 2 * hstepB;
#define PG8_ABASE(u) ((const char*)g.A + (size_t)(u).pm * tstepA + (g.acol_shift >= 0 ? (size_t)(((u).pn >> g.acol_shift) * 512) : (size_t)0))
    const unsigned ldsw = (unsigned)wid * 1024u;
    const int aoff = lds_byte(wr * 64 + fr, fq * 8), boff = lds_byte(wc * 32 + fr, fq * 8);
#define PG8_SA(b, h) (((b) * 2 + (h)) * HTB)
#define PG8_SB(b, h) ((4 + (b) * 2 + (h)) * HTB)
#define PG8_STAGE(bufoff, gbase, voff) do { _Pragma("unroll") for (int _i = 0; _i < 2; ++_i) \
        __builtin_amdgcn_global_load_lds((const unsigned*)((const char*)(gbase) + (voff)[_i]), (PG8_LAS unsigned*)(lds + (bufoff) + ldsw + _i * 8192), 16, 0, 0); } while (0)
#define PG8_LDA(dst, b, h) do { _Pragma("unroll") for (int m = 0; m < 4; ++m) _Pragma("unroll") for (int k = 0; k < 2; ++k) dst[m][k] = *(const PG8_LAS bf16x8*)(lds + PG8_SA(b, h) + aoff + m * 2048 + k * 1024); } while (0)
#define PG8_LDB(dst, b, h) do { _Pragma("unroll") for (int n = 0; n < 2; ++n) _Pragma("unroll") for (int k = 0; k < 2; ++k) dst[n][k] = *(const PG8_LAS bf16x8*)(lds + PG8_SB(b, h) + boff + n * 2048 + k * 1024); } while (0)
#define PG8_MMA(ai, bj, At, Bt) do { __builtin_amdgcn_s_setprio(1); _Pragma("unroll") for (int m = 0; m < 4; ++m) _Pragma("unroll") for (int n = 0; n < 2; ++n) _Pragma("unroll") for (int k = 0; k < 2; ++k) \
        acc[ai][bj][m][n] = __builtin_amdgcn_mfma_f32_16x16x32_bf16(Bt[n][k], At[m][k], acc[ai][bj][m][n], 0, 0, 0); __builtin_amdgcn_s_setprio(0); } while (0)
#define PG8_WAIT_V(n) asm volatile("s_waitcnt vmcnt(" #n ")" ::: "memory")
#define PG8_WAIT_L(n) asm volatile("s_waitcnt lgkmcnt(" #n ")" ::: "memory")
#define PG8_BAR __builtin_amdgcn_s_barrier()
#define PG8_SCHED __builtin_amdgcn_sched_barrier(0)
    Unit cur, nxt; int ui = 0;
    if (!S.next(0, cur)) return;
    f32x4 acc[2][2][4][2];
#pragma unroll
    for (int a = 0; a < 2; ++a)
#pragma unroll
        for (int b = 0; b < 2; ++b)
#pragma unroll
            for (int m = 0; m < 4; ++m)
#pragma unroll
                for (int n = 0; n < 2; ++n) acc[a][b][m][n] = (f32x4){0.f, 0.f, 0.f, 0.f};
    bf16x8 At[4][2], B0[2][2], B1[2][2];
    const char* cA = PG8_ABASE(cur); const char* cB = (const char*)g.Bt + (size_t)cur.pn * tstepB;
    S.a_ready(cur);
    if constexpr (SP2) {
        PG8_STAGE(PG8_SB(0, 0), cB, voffB); PG8_STAGE(PG8_SB(0, 1), cB + hstepB, voffB); PG8_STAGE(PG8_SA(0, 0), cA, voffA); PG8_STAGE(PG8_SA(0, 1), cA + hstepA, voffA);
        if (wr == 1) PG8_BAR;
        PG8_WAIT_V(2); PG8_BAR;
        PG8_STAGE(PG8_SB(1, 0), cB + kstep, voffB); PG8_STAGE(PG8_SA(1, 0), cA + kstep, voffA); PG8_STAGE(PG8_SB(1, 1), cB + hstepB + kstep, voffB);
        PG8_WAIT_V(6); PG8_BAR;
    } else {
        PG8_STAGE(PG8_SB(0, 0), cB, voffB); PG8_STAGE(PG8_SA(0, 0), cA, voffA); PG8_STAGE(PG8_SB(0, 1), cB + hstepB, voffB); PG8_STAGE(PG8_SA(0, 1), cA + hstepA, voffA);
        if (wr == 1) PG8_BAR;
        PG8_WAIT_V(4); PG8_BAR;
        PG8_STAGE(PG8_SB(1, 0), cB + kstep, voffB); PG8_STAGE(PG8_SA(1, 0), cA + kstep, voffA); PG8_STAGE(PG8_SB(1, 1), cB + hstepB + kstep, voffB);
        PG8_WAIT_V(6); PG8_BAR;
    }
    for (;;) {
        const bool has_next = S.next(ui + 1, nxt);
        const char* nA = has_next ? PG8_ABASE(nxt) : cA; const char* nB = has_next ? (const char*)g.Bt + (size_t)nxt.pn * tstepB : cB;
#pragma nounroll
        for (int t = 0; t < nt; t += 2) {
            const bool last = (t == nt - 2);
            const char* a1 = cA + (size_t)(t + 1) * kstep;
            const char* a2 = last ? nA : cA + (size_t)(t + 2) * kstep; const char* b2 = last ? nB : cB + (size_t)(t + 2) * kstep;
            const char* a3 = a2 + kstep; const char* b3 = b2 + kstep;
            if (last && has_next) S.a_ready(nxt);
            if constexpr (SP2) {
            PG8_LDB(B0, 0, 0); PG8_LDB(B1, 0, 1); PG8_SCHED; PG8_LDA(At, 0, 0); PG8_STAGE(PG8_SA(1, 1), a1 + hstepA, voffA);
            PG8_WAIT_V(8); PG8_WAIT_L(0); PG8_BAR; PG8_MMA(0, 0, At, B0); PG8_MMA(0, 1, At, B1); PG8_BAR; PG8_SCHED;
            PG8_LDA(At, 0, 1); PG8_STAGE(PG8_SB(0, 0), b2, voffB); PG8_STAGE(PG8_SB(0, 1), b2 + hstepB, voffB); PG8_STAGE(PG8_SA(0, 0), a2, voffA);
            PG8_WAIT_V(8); PG8_WAIT_L(0); PG8_BAR; PG8_MMA(1, 0, At, B0); PG8_MMA(1, 1, At, B1); PG8_BAR; PG8_SCHED;
            PG8_LDB(B0, 1, 0); PG8_LDB(B1, 1, 1); PG8_SCHED; PG8_LDA(At, 1, 0); PG8_STAGE(PG8_SA(0, 1), a2 + hstepA, voffA);
            PG8_WAIT_V(8); PG8_WAIT_L(0); PG8_BAR; PG8_MMA(0, 0, At, B0); PG8_MMA(0, 1, At, B1); PG8_BAR; PG8_SCHED;
            PG8_LDA(At, 1, 1); PG8_STAGE(PG8_SB(1, 0), b3, voffB); PG8_STAGE(PG8_SB(1, 1), b3 + hstepB, voffB); PG8_STAGE(PG8_SA(1, 0), a3, voffA);
            PG8_WAIT_V(8); PG8_WAIT_L(0); PG8_BAR; PG8_MMA(1, 0, At, B0); PG8_MMA(1, 1, At, B1); PG8_BAR; PG8_SCHED;
            } else {
            PG8_LDB(B0, 0, 0); PG8_SCHED; PG8_LDA(At, 0, 0); PG8_STAGE(PG8_SA(1, 1), a1 + hstepA, voffA);
            PG8_WAIT_L(8); PG8_BAR; PG8_WAIT_L(0); PG8_MMA(0, 0, At, B0); PG8_BAR; PG8_SCHED;
            PG8_LDB(B1, 0, 1); PG8_STAGE(PG8_SB(0, 0), b2, voffB);
            PG8_BAR; PG8_WAIT_L(0); PG8_MMA(0, 1, At, B1); PG8_BAR;
            PG8_LDA(At, 0, 1); PG8_STAGE(PG8_SA(0, 0), a2, voffA);
            PG8_BAR; PG8_WAIT_L(0); PG8_MMA(1, 0, At, B0); PG8_BAR; PG8_SCHED;
            PG8_STAGE(PG8_SB(0, 1), b2 + hstepB, voffB);
            PG8_WAIT_V(6); PG8_BAR; PG8_MMA(1, 1, At, B1); PG8_BAR;
            PG8_LDB(B0, 1, 0); PG8_SCHED; PG8_LDA(At, 1, 0); PG8_STAGE(PG8_SA(0, 1), a2 + hstepA, voffA);
            PG8_WAIT_L(8); PG8_BAR; PG8_WAIT_L(0); PG8_MMA(0, 0, At, B0); PG8_BAR; PG8_SCHED;
            PG8_LDB(B1, 1, 1); PG8_STAGE(PG8_SB(1, 0), b3, voffB);
            PG8_BAR; PG8_WAIT_L(0); PG8_MMA(0, 1, At, B1); PG8_BAR;
            PG8_LDA(At, 1, 1); PG8_STAGE(PG8_SA(1, 0), a3, voffA);
            PG8_BAR; PG8_WAIT_L(0); PG8_MMA(1, 0, At, B0); PG8_BAR; PG8_SCHED;
            PG8_STAGE(PG8_SB(1, 1), b3 + hstepB, voffB);
            PG8_WAIT_V(6); PG8_BAR; PG8_MMA(1, 1, At, B1); PG8_BAR;
            }
        }
        if constexpr (ALIGN_EPI) { if (wr == 0) PG8_BAR; }
        if constexpr (!Epi::AFTER_DRAIN) { E(acc, cur, wr, wc, fr, fq); S.done(cur); }
        if (!has_next) break;
#pragma unroll
        for (int a = 0; a < 2; ++a)
#pragma unroll
            for (int b = 0; b < 2; ++b)
#pragma unroll
                for (int m = 0; m < 4; ++m)
#pragma unroll
                    for (int n = 0; n < 2; ++n) acc[a][b][m][n] = (f32x4){0.f, 0.f, 0.f, 0.f};
        cur = nxt; cA = nA; cB = nB; ++ui;
        if constexpr (ALIGN_EPI) { if (wr == 1) PG8_BAR; }
    }
    PG8_WAIT_V(0);
    if constexpr (!ALIGN_EPI) { if (wr == 0) PG8_BAR; }
    PG8_BAR;
    if constexpr (Epi::AFTER_DRAIN) { E.fused(acc, cur, wr, wc, fr, fq, lds, wid, lane); S.done(cur); }
#undef PG8_ABASE
#undef PG8_SA
#undef PG8_SB
#undef PG8_STAGE
#undef PG8_LDA
#undef PG8_LDB
#undef PG8_MMA
#undef PG8_WAIT_V
#undef PG8_WAIT_L
#undef PG8_BAR
#undef PG8_SCHED
}
}
#define XB_TMO      128
#define XB_XCNT(j)  (256  + 64 * (j))
#define XB_XSUB(j)  (1280 + 64 * (j))
#define XB_XGEN(j)  (2304 + 64 * (j))
#define XB_TOP      3328
#define XB_TOPGEN   3392
#define XCD_BAR_WORDS 3456
#define XB_SPIN_CAP (1u << 18)

__device__ __forceinline__ unsigned xb_ld(unsigned* p)              { return __hip_atomic_load(p, __ATOMIC_RELAXED, __HIP_MEMORY_SCOPE_AGENT); }
__device__ __forceinline__ unsigned xb_add(unsigned* p, unsigned v) { return __hip_atomic_fetch_add(p, v, __ATOMIC_RELAXED, __HIP_MEMORY_SCOPE_AGENT); }
__device__ __forceinline__ unsigned xb_xcc_id() { return (unsigned)__builtin_amdgcn_s_getreg((3 << 11) | 20) & 0xFu; }
#define XB_SPIN(cond, bar) do { unsigned _sp = 0; while (cond) { __builtin_amdgcn_s_sleep(1); \
    if ((++_sp & 255u) == 0u) { if (xb_ld(&(bar)[XB_TMO])) break; if (_sp > XB_SPIN_CAP) { atomicAdd(&(bar)[XB_TMO], 1u); break; } } } } while (0)

struct XcdBarrier {
    unsigned* bar; unsigned x;
    volatile LAS unsigned* st;
};

__device__ __forceinline__ XcdBarrier xcd_barrier_post(unsigned* bar, volatile LAS unsigned* st) {
    XcdBarrier b; b.bar = bar; b.x = xb_xcc_id(); b.st = st;
    if (threadIdx.x == 0) (void)xb_add(&bar[XB_XCNT(b.x)], 1u);
    return b;
}
__device__ __forceinline__ void xcd_barrier_complete(unsigned* bar, unsigned x, unsigned& nloc, unsigned& nx) {
    const unsigned G = gridDim.x * gridDim.y * gridDim.z;
    unsigned sum, cnt, mine, sp = 0u;
    for (;;) {
        sum = 0u; cnt = 0u; mine = 0u;
#pragma unroll
        for (unsigned j = 0; j < 16; ++j) { const unsigned c = xb_ld(&bar[XB_XCNT(j)]); sum += c; cnt += (c > 0u) ? 1u : 0u; mine = (j == x) ? c : mine; }
        if (sum == G) break;
        __builtin_amdgcn_s_sleep(1);
        if ((++sp & 255u) == 0u) { if (xb_ld(&bar[XB_TMO])) break; if (sp > XB_SPIN_CAP) { atomicAdd(&bar[XB_TMO], 1u); break; } }
    }
    nloc = mine > 0u ? mine : 1u; nx = cnt > 0u ? cnt : 1u;
}

__device__ __forceinline__ void xcd_barrier(const XcdBarrier& b) {
    asm volatile("s_waitcnt vmcnt(0)" ::: "memory");
    __syncthreads();
    if (threadIdx.x == 0) {
        unsigned* bar = b.bar;
        __builtin_amdgcn_s_waitcnt(0);
        unsigned nloc = b.st[0], nx = b.st[1];
        if (nloc == 0u) { xcd_barrier_complete(bar, b.x, nloc, nx); b.st[0] = nloc; b.st[1] = nx; }
        const unsigned old = xb_add(&bar[XB_XSUB(b.x)], 1u);
        const unsigned gen = old / nloc;
        if (old + 1u == (gen + 1u) * nloc) {
            __builtin_amdgcn_fence(__ATOMIC_RELEASE, "agent");
            asm volatile("s_waitcnt vmcnt(0)" ::: "memory");
            const unsigned og = xb_add(&bar[XB_TOP], 1u);
            const unsigned tg = og / nx;
            if (og + 1u == (tg + 1u) * nx) xb_add(&bar[XB_TOPGEN], 1u);
            else XB_SPIN(xb_ld(&bar[XB_TOPGEN]) == tg, bar);
            __builtin_amdgcn_fence(__ATOMIC_ACQUIRE, "agent");
            xb_add(&bar[XB_XGEN(b.x)], 1u);
            asm volatile("s_waitcnt vmcnt(0)" ::: "memory");
        } else {
            XB_SPIN(xb_ld(&bar[XB_XGEN(b.x)]) == gen, bar);
            __builtin_amdgcn_fence(__ATOMIC_ACQUIRE, "agent");
            asm volatile("s_waitcnt vmcnt(0)" ::: "memory");
        }
    }
    __syncthreads();
}
struct Frame {
    LAS unsigned char* lds;
    volatile LAS unsigned* MISC;
    gu32* ctl;
    int tid, lane, wave;
    int vcu, G;
    unsigned char* ws;
    const float* in[21];
    float* out;
};
__device__ __forceinline__ int prev_row(int r) { return r == SEQ ? -1 : (r == 0 ? LTOK - 1 : r - 1); }
__device__ __forceinline__ const float* base_row(const Frame& F, int r) { return r < SEQ ? F.in[0] + (size_t)r * DM : F.in[1] + (size_t)(r - SEQ) * DM; }

__device__ __forceinline__ void transpose_item(const float* W, int N, bf16* WT, int ldk, int k0, int n0, int drow0, LAS float* scr, int lane) {
#pragma unroll 8
    for (int i = 0; i < 32; ++i) { const int kk = 2 * i + (lane >> 5); scr[kk * 33 + (lane & 31)] = W[(size_t)(k0 + kk) * N + n0 + (lane & 31)]; }
    LDS_WAIT(); asm volatile("" ::: "memory");
    const int c = lane & 7;
#pragma unroll
    for (int j = 0; j < 4; ++j) { const int n = (lane >> 3) + 8 * j; const LAS float* s = scr + (8 * c) * 33 + n;
        v4u o; o.x = pk2(s[0 * 33], s[1 * 33]); o.y = pk2(s[2 * 33], s[3 * 33]); o.z = pk2(s[4 * 33], s[5 * 33]); o.w = pk2(s[6 * 33], s[7 * 33]);
        *(GAS v4u*)(WT + (size_t)(drow0 + n) * ldk + k0 + 8 * c) = o; }
    LDS_WAIT(); asm volatile("" ::: "memory");
}
__device__ __forceinline__ void tr_plain(const float* W, int K, int N, bf16* WT, int item, LAS float* scr, int lane) {
    const int nblk = N / 32, kb = item / nblk, nb = item % nblk; transpose_item(W, N, WT, K, 64 * kb, 32 * nb, 32 * nb, scr, lane);
}
__device__ __forceinline__ void tr_gu(const float* W, bf16* WT, int item, LAS float* scr, int lane) {
    const int nblk = (2 * DFF) / 32, kb = item / nblk, nb = item % nblk, n0 = 32 * nb; const int isup = n0 >= DFF, c0 = isup ? n0 - DFF : n0;
    transpose_item(W, 2 * DFF, WT, DM, 64 * kb, n0, 256 * (c0 >> 7) + (c0 & 127) + (isup ? 128 : 0), scr, lane);
}
__device__ __forceinline__ void tr_lru(const float* W, bf16* WT, int isx, int item, LAS float* scr, int lane) {
    const int h = item >> 5, r = item & 31, kb = r >> 3, nb = r & 7, j0 = 32 * nb;
    transpose_item(W + (size_t)h * 65536, 256, WT, 256, 64 * kb, j0, 256 * (2 * h + (j0 >> 7)) + (j0 & 127) + (isx ? 128 : 0), scr, lane);
}
__device__ __forceinline__ void rms_row_to_bf16(const Frame& F, const float* xrow, const float* w, bf16* orow) {
    const GAS f32x4* xr = (const GAS f32x4*)xrow + F.lane; const GAS f32x4* wr = (const GAS f32x4*)w + F.lane;
    f32x4 v[16]; float s = 0.f;
#pragma unroll
    for (int j = 0; j < 16; ++j) { v[j] = xr[64 * j]; s += (v[j].x * v[j].x + v[j].y * v[j].y) + (v[j].z * v[j].z + v[j].w * v[j].w); }
    const float rstd = 1.0f / sqrtf(wave_sum(s) * (1.f / DM) + NORM_EPS);
    GAS v2u* o8 = (GAS v2u*)orow + F.lane;
#pragma unroll
    for (int j = 0; j < 16; ++j) { const f32x4 g = wr[64 * j]; v2u o; o.x = pk2(v[j].x * rstd * g.x, v[j].y * rstd * g.y); o.y = pk2(v[j].z * rstd * g.z, v[j].w * rstd * g.w); o8[64 * j] = o; }
}
__device__ __forceinline__ void p0_prologue(Frame& F) {
    LAS float* scr = (LAS float*)(F.lds + RING_OFF + F.wave * 16384);
    const int gw = F.vcu * NWAVES + F.wave, NGW = F.G * NWAVES;
    constexpr int I_INE = (DM / 64) * (EVEN_IN / 32), I_44 = (DM / 64) * (DM / 32), I_INO = (DM / 64) * (8192 / 32), I_LRU = 16 * 32, I_GU = (DM / 64) * (2 * DFF / 32), I_D = (DFF / 64) * (DM / 32);
    constexpr int NITEMS = I_INE + I_44 + I_INO + 2 * I_LRU + I_44 + 2 * I_GU + 2 * I_D;
    unsigned char* ws = F.ws;
    for (int it = gw; it < NITEMS; it += NGW) {
        int r = it;
        if (r < I_INE) { tr_plain(F.in[3], DM, EVEN_IN, (bf16*)(ws + WS_WIN_E), r, scr, F.lane); continue; } r -= I_INE;
        if (r < I_44) { tr_plain(F.in[7], DM, DM, (bf16*)(ws + WS_WOUT_E), r, scr, F.lane); continue; } r -= I_44;
        if (r < I_INO) { tr_plain(F.in[8], DM, 8192, (bf16*)(ws + WS_WIN_O), r, scr, F.lane); continue; } r -= I_INO;
        if (r < I_LRU) { tr_lru(F.in[11], (bf16*)(ws + WS_WG), 0, r, scr, F.lane); continue; } r -= I_LRU;
        if (r < I_LRU) { tr_lru(F.in[13], (bf16*)(ws + WS_WG), 1, r, scr, F.lane); continue; } r -= I_LRU;
        if (r < I_44) { tr_plain(F.in[16], DM, DM, (bf16*)(ws + WS_WOUT_O), r, scr, F.lane); continue; } r -= I_44;
        if (r < 2 * I_GU) { const int L = r / I_GU; tr_gu(F.in[17] + (size_t)L * DM * 2 * DFF, (bf16*)(ws + WS_WGU + (size_t)L * SZ_WGU), r % I_GU, scr, F.lane); continue; } r -= 2 * I_GU;
        { const int L = r / I_D; tr_plain(F.in[20] + (size_t)L * DFF * DM, DFF, DM, (bf16*)(ws + WS_WD + (size_t)L * SZ_WD), r % I_D, scr, F.lane); }
    }
    for (int c = F.vcu * 512 + F.tid; c < DM; c += F.G * 512) { const float p = F.in[15][c]; ((float*)(ws + WS_LS8))[c] = -8.0f * (fmaxf(-p, 0.f) + log1pf(expf(-fabsf(p)))); }
    for (int m = gw; m < LTOK; m += NGW) rms_row_to_bf16(F, base_row(F, m), F.in[2], (bf16*)(ws + WS_XN) + (size_t)m * DM);
}

__device__ __forceinline__ void norm_pass(const Frame& F, const float* src, int base_is_input, const float* hin, const float* wA, const float* wB, float* hout, bf16* xn, int final_out) {
    const int gw = F.vcu * NWAVES + F.wave, NGW = F.G * NWAVES;
    for (int r = gw; r < LTOK; r += NGW) {
        if (final_out && r >= SEQ) continue;
        const GAS f32x4* sr = (const GAS f32x4*)(src + (size_t)r * DM) + F.lane;
        const GAS f32x4* br = (const GAS f32x4*)(base_is_input ? base_row(F, r) : hin + (size_t)r * DM) + F.lane;
        const GAS f32x4* wa = (const GAS f32x4*)wA + F.lane;
        f32x4 v[16]; float s = 0.f;
#pragma unroll
        for (int j = 0; j < 16; ++j) { v[j] = sr[64 * j]; s += (v[j].x * v[j].x + v[j].y * v[j].y) + (v[j].z * v[j].z + v[j].w * v[j].w); }
        const float rstd = 1.0f / sqrtf(wave_sum(s) * (1.f / DM) + NORM_EPS);
        GAS f32x4* ho = (GAS f32x4*)(hout + (size_t)r * DM) + F.lane;
        float s2 = 0.f;
#pragma unroll
        for (int j = 0; j < 16; ++j) { const f32x4 g = wa[64 * j], b = br[64 * j]; v[j] = b + v[j] * rstd * g; ho[64 * j] = v[j]; s2 += (v[j].x * v[j].x + v[j].y * v[j].y) + (v[j].z * v[j].z + v[j].w * v[j].w); if ((j & 3) == 3) asm volatile("" ::: "memory"); }
        if (xn) {
            const float rstd2 = 1.0f / sqrtf(wave_sum(s2) * (1.f / DM) + NORM_EPS);
            const GAS f32x4* wb = (const GAS f32x4*)wB + F.lane; GAS v2u* o8 = (GAS v2u*)(xn + (size_t)r * DM) + F.lane;
#pragma unroll
            for (int j = 0; j < 16; ++j) { const f32x4 g = wb[64 * j]; v2u o; o.x = pk2(v[j].x * rstd2 * g.x, v[j].y * rstd2 * g.y); o.y = pk2(v[j].z * rstd2 * g.z, v[j].w * rstd2 * g.w); o8[64 * j] = o; if ((j & 3) == 3) asm volatile("" ::: "memory"); }
        }
    }
}

__device__ __forceinline__ void ffn_act_pass(const Frame& F, const float* G, const bf16* U, const float* cw, const float* cb, bf16* ACT) {
    const int gw = F.vcu * NWAVES + F.wave, NGW = F.G * NWAVES;
    constexpr int NCG = DFF / 256, NRB = LTOK / 16;
    for (int it = gw; it < NCG * NRB; it += NGW) {
        const int rb = it / NCG, cg = it % NCG, r0 = 16 * rb, c = cg * 256 + 4 * F.lane;
        const f32x4 w0 = *(const GAS f32x4*)(cw + c), w1 = *(const GAS f32x4*)(cw + DFF + c), w2 = *(const GAS f32x4*)(cw + 2 * DFF + c), bb = *(const GAS f32x4*)(cb + c);
        f32x4 gm2 = (f32x4){0.f, 0.f, 0.f, 0.f}, gm1 = gm2;
        if (r0 != SEQ) { const int p1 = prev_row(r0), p2 = prev_row(p1); gm1 = *(const GAS f32x4*)(G + (size_t)p1 * DFF + c); gm2 = *(const GAS f32x4*)(G + (size_t)p2 * DFF + c); }
#pragma unroll 4
        for (int i = 0; i < 16; ++i) { const size_t off = (size_t)(r0 + i) * DFF + c;
            const f32x4 g = *(const GAS f32x4*)(G + off); const v2u uu = *(const GAS v2u*)(U + off);
            const f32x4 v = bb + w0 * gm2 + w1 * gm1 + w2 * g;
            v2u o; o.x = pk2(fgelu_tanh(v.x) * bflo(uu.x), fgelu_tanh(v.y) * bfhi(uu.x)); o.y = pk2(fgelu_tanh(v.z) * bflo(uu.y), fgelu_tanh(v.w) * bfhi(uu.y));
            *(GAS v2u*)(ACT + off) = o; gm2 = gm1; gm1 = g; }
    }
}

__device__ __forceinline__ void lru_conv_pass(const Frame& F, const float* X, const float* cw, const float* cb, float* XC, bf16* XCB) {
    const int gw = F.vcu * NWAVES + F.wave, NGW = F.G * NWAVES;
    constexpr int NCG = DM / 256, NRB = LTOK / 16;
    for (int it = gw; it < NCG * NRB; it += NGW) {
        const int rb = it / NCG, cg = it % NCG, r0 = 16 * rb, c = cg * 256 + 4 * F.lane;
        const f32x4 w0 = *(const GAS f32x4*)(cw + c), w1 = *(const GAS f32x4*)(cw + DM + c), w2 = *(const GAS f32x4*)(cw + 2 * DM + c), w3 = *(const GAS f32x4*)(cw + 3 * DM + c), bb = *(const GAS f32x4*)(cb + c);
        f32x4 x3 = (f32x4){0.f, 0.f, 0.f, 0.f}, x2 = x3, x1 = x3;
        if (r0 != SEQ) { const int p1 = prev_row(r0), p2 = prev_row(p1), p3 = prev_row(p2);
            x1 = *(const GAS f32x4*)(X + (size_t)p1 * DM + c); x2 = *(const GAS f32x4*)(X + (size_t)p2 * DM + c); x3 = *(const GAS f32x4*)(X + (size_t)p3 * DM + c); }
#pragma unroll 4
        for (int i = 0; i < 16; ++i) { const size_t off = (size_t)(r0 + i) * DM + c;
            const f32x4 x = *(const GAS f32x4*)(X + off);
            const f32x4 v = bb + w0 * x3 + w1 * x2 + w2 * x1 + w3 * x;
            *(GAS f32x4*)(XC + off) = v; v2u o; o.x = pk2(v.x, v.y); o.y = pk2(v.z, v.w); *(GAS v2u*)(XCB + off) = o;
            x3 = x2; x2 = x1; x1 = x; }
    }
}

__device__ __forceinline__ void seg_rows(int s, int& r0, int& n) { if (s == 0) { r0 = SEQ; n = NMETA; } else { r0 = 64 * (s - 1); n = 64; } }
__device__ __forceinline__ void lru_scan1(const Frame& F, const unsigned* AB, float* CA, float* CB) {
    const int gw = F.vcu * NWAVES + F.wave, NGW = F.G * NWAVES;
    for (int it = gw; it < NCHUNK * 16; it += NGW) {
        const int s = it >> 4, c = (it & 15) * 256 + 4 * F.lane; int r0, n; seg_rows(s, r0, n);
        f32x4 pl = (f32x4){0.f, 0.f, 0.f, 0.f}, h = pl;
#pragma unroll 8
        for (int i = 0; i < n; ++i) { const v4u w = *(const GAS v4u*)(AB + (size_t)(r0 + i) * DM + c);
            const f32x4 la = (f32x4){bflo(w.x), bflo(w.y), bflo(w.z), bflo(w.w)}, b = (f32x4){bfhi(w.x), bfhi(w.y), bfhi(w.z), bfhi(w.w)};
            const f32x4 a = (f32x4){fexp(la.x), fexp(la.y), fexp(la.z), fexp(la.w)}; h = a * h + b; pl = pl + la; }
        *(GAS f32x4*)(CA + (size_t)s * DM + c) = (f32x4){fexp(pl.x), fexp(pl.y), fexp(pl.z), fexp(pl.w)}; *(GAS f32x4*)(CB + (size_t)s * DM + c) = h;
    }
}
__device__ __forceinline__ void lru_scan2(const Frame& F, const unsigned* AB, const float* CA, const float* CB, const bf16* Y, bf16* LO) {
    const int gw = F.vcu * NWAVES + F.wave, NGW = F.G * NWAVES;
    for (int it = gw; it < NCHUNK * 16; it += NGW) {
        const int s = it >> 4, c = (it & 15) * 256 + 4 * F.lane; int r0, n; seg_rows(s, r0, n);
        f32x4 h = (f32x4){0.f, 0.f, 0.f, 0.f};
#pragma unroll 8
        for (int j = 0; j < s; ++j) { const f32x4 a = *(const GAS f32x4*)(CA + (size_t)j * DM + c), b = *(const GAS f32x4*)(CB + (size_t)j * DM + c); h = a * h + b; }
#pragma unroll 8
        for (int i = 0; i < n; ++i) { const size_t off = (size_t)(r0 + i) * DM + c; const v4u w = *(const GAS v4u*)(AB + off); const v2u yy = *(const GAS v2u*)(Y + off);
            const f32x4 a = (f32x4){fexp(bflo(w.x)), fexp(bflo(w.y)), fexp(bflo(w.z)), fexp(bflo(w.w))}, b = (f32x4){bfhi(w.x), bfhi(w.y), bfhi(w.z), bfhi(w.w)};
            h = a * h + b; v2u o; o.x = pk2(h.x * bflo(yy.x), h.y * bfhi(yy.x)); o.y = pk2(h.z * bflo(yy.y), h.w * bfhi(yy.y)); *(GAS v2u*)(LO + off) = o; }
    }
}
__device__ __forceinline__ void ffn_fixup(const Frame& F, const float* HG, const float* HU, const float* cw, const float* cb, bf16* ACT) {
    constexpr int NQ = DFF / 4;
    for (int task = F.vcu * 512 + F.tid; task < 128 * NQ; task += F.G * 512) {
        const int k = task / NQ, c = (task % NQ) * 4, pv = (k == 0) ? 128 : k - 1;
        const f32x4 w0 = *(const GAS f32x4*)(cw + c), w1 = *(const GAS f32x4*)(cw + DFF + c), w2 = *(const GAS f32x4*)(cw + 2 * DFF + c), bb = *(const GAS f32x4*)(cb + c);
        const f32x4 g62 = *(const GAS f32x4*)(HG + (size_t)(pv * 4 + 2) * DFF + c), g63 = *(const GAS f32x4*)(HG + (size_t)(pv * 4 + 3) * DFF + c);
        const f32x4 g0 = *(const GAS f32x4*)(HG + (size_t)(k * 4 + 0) * DFF + c), g1 = *(const GAS f32x4*)(HG + (size_t)(k * 4 + 1) * DFF + c);
        const f32x4 u0 = *(const GAS f32x4*)(HU + (size_t)(k * 2 + 0) * DFF + c), u1 = *(const GAS f32x4*)(HU + (size_t)(k * 2 + 1) * DFF + c);
        const f32x4 v0 = bb + w0 * g62 + w1 * g63 + w2 * g0, v1 = bb + w0 * g63 + w1 * g0 + w2 * g1;
        v2u o0, o1; o0.x = pk2(fgelu_tanh(v0.x) * u0.x, fgelu_tanh(v0.y) * u0.y); o0.y = pk2(fgelu_tanh(v0.z) * u0.z, fgelu_tanh(v0.w) * u0.w);
        o1.x = pk2(fgelu_tanh(v1.x) * u1.x, fgelu_tanh(v1.y) * u1.y); o1.y = pk2(fgelu_tanh(v1.z) * u1.z, fgelu_tanh(v1.w) * u1.w);
        *(GAS v2u*)(ACT + (size_t)(64 * k) * DFF + c) = o0; *(GAS v2u*)(ACT + (size_t)(64 * k + 1) * DFF + c) = o1;
    }
}
__device__ __forceinline__ f32x4 mma_nt(const LAS bf16* A, int lda, const LAS bf16* B, int ldb, int nks, f32x4 acc, int lane) {
    const LAS bf16* ap = A + (lane & 15) * lda + 8 * (lane >> 4); const LAS bf16* bp = B + (lane & 15) * ldb + 8 * (lane >> 4);
    for (int ks = 0; ks < nks; ++ks) { const bf16x8 a = *(const LAS bf16x8*)(ap + 32 * ks), b = *(const LAS bf16x8*)(bp + 32 * ks); acc = __builtin_amdgcn_mfma_f32_16x16x32_bf16(a, b, acc, 0, 0, 0); }
    return acc;
}
__device__ __forceinline__ int hg_row(int n, int t) { return n == 0 ? (t < 48 ? -1 : SEQ + t - 48) : 64 * (n - 1) + t; }
__device__ __forceinline__ void hg_load_vt(const bf16* VA, int hh, int n, LAS bf16* VT, int tid) {
    const int t = tid >> 3, vs = (tid & 7) * 16, r = hg_row(n, t);
    v4u a = (v4u){0u, 0u, 0u, 0u}, b = a;
    if (r >= 0) { const GAS v4u* p = (const GAS v4u*)(VA + (size_t)r * 2048 + hh * 128 + vs); a = p[0]; b = p[1]; }
    const unsigned w[8] = {a.x, a.y, a.z, a.w, b.x, b.y, b.z, b.w};
#pragma unroll
    for (int j = 0; j < 8; ++j) { VT[(vs + 2 * j) * 72 + t] = (bf16)(w[j] & 0xffffu); VT[(vs + 2 * j + 1) * 72 + t] = (bf16)(w[j] >> 16); }
}
__device__ __forceinline__ void hgrn_h1(const Frame& F, const float* GL, const bf16* VA, float* US, float* DS) {
    LAS bf16* KT = (LAS bf16*)(F.lds + 0);
    LAS bf16* VT = (LAS bf16*)(F.lds + 18432);
    LAS float* TOT = (LAS float*)(F.lds + 36864);
    const int tid = F.tid, lane = F.lane, w = F.wave, k = tid & 127, sc = tid >> 7;
    for (int unit = F.vcu; unit < A_HEADS * NCHUNK; unit += F.G) {
        const int hh = unit / NCHUNK, n = unit % NCHUNK;
        float g[16], cs[16]; float run = 0.f;
#pragma unroll
        for (int i = 0; i < 16; ++i) { const int r = hg_row(n, 16 * sc + i); g[i] = r >= 0 ? GL[(size_t)r * 2048 + hh * 128 + k] : 0.f; }
#pragma unroll
        for (int i = 0; i < 16; ++i) { run += g[i]; cs[i] = run; }
        TOT[sc * 128 + k] = run;
        hg_load_vt(VA, hh, n, VT, tid);
        __syncthreads();
        float off = 0.f, total = 0.f;
#pragma unroll
        for (int j = 0; j < 4; ++j) { const float tj = TOT[j * 128 + k]; off += (j < sc) ? tj : 0.f; total += tj; }
        unsigned pk[8];
#pragma unroll
        for (int i = 0; i < 8; ++i) { const float e0 = (1.0f - fexp(g[2 * i])) * fexp(total - off - cs[2 * i]), e1 = (1.0f - fexp(g[2 * i + 1])) * fexp(total - off - cs[2 * i + 1]); pk[i] = pk2(e0, e1); }
        *(LAS v4u*)(KT + k * 72 + 16 * sc) = (v4u){pk[0], pk[1], pk[2], pk[3]}; *(LAS v4u*)(KT + k * 72 + 16 * sc + 8) = (v4u){pk[4], pk[5], pk[6], pk[7]};
        if (sc == 0) DS[(size_t)unit * 128 + k] = fexp(total);
        __syncthreads();
        float* up = US + (size_t)unit * 16384 + (size_t)(16 * w + 4 * (lane >> 4)) * 128 + (lane & 15);
#pragma unroll
        for (int vb = 0; vb < 8; ++vb) { f32x4 acc = (f32x4){0.f, 0.f, 0.f, 0.f}; acc = mma_nt(KT + 16 * w * 72, 72, VT + 16 * vb * 72, 72, 2, acc, lane);
#pragma unroll
            for (int rg = 0; rg < 4; ++rg) up[rg * 128 + 16 * vb] = acc[rg]; }
        __syncthreads();
    }
}
__device__ __forceinline__ void hgrn_h2(const Frame& F, const float* US, const float* DS, bf16* SS) {
    const int e = F.vcu * 512 + F.tid, stride = F.G * 512; constexpr int TOTAL = A_HEADS * 16384;
    for (int idx = e; idx < TOTAL; idx += 2 * stride) {
        const int i0 = idx, i1 = (idx + stride < TOTAL) ? idx + stride : idx; const bool two = idx + stride < TOTAL;
        const float* p0 = US + (size_t)(i0 >> 14) * NCHUNK * 16384 + (i0 & 16383); const float* d0 = DS + (size_t)(i0 >> 14) * NCHUNK * 128 + ((i0 & 16383) >> 7); bf16* o0 = SS + (size_t)(i0 >> 14) * NCHUNK * 16384 + (i0 & 16383);
        const float* p1 = US + (size_t)(i1 >> 14) * NCHUNK * 16384 + (i1 & 16383); const float* d1 = DS + (size_t)(i1 >> 14) * NCHUNK * 128 + ((i1 & 16383) >> 7); bf16* o1 = SS + (size_t)(i1 >> 14) * NCHUNK * 16384 + (i1 & 16383);
        float S0 = 0.f, S1 = 0.f;
        for (int n0 = 0; n0 < NCHUNK; n0 += 16) {
            float u0[16], u1[16], e0[16], e1[16];
#pragma unroll
            for (int j = 0; j < 16; ++j) { const int n = (n0 + j < NCHUNK) ? n0 + j : NCHUNK - 1; u0[j] = p0[(size_t)n * 16384]; e0[j] = d0[n * 128]; u1[j] = p1[(size_t)n * 16384]; e1[j] = d1[n * 128]; }
#pragma unroll
            for (int j = 0; j < 16; ++j) { const int n = n0 + j; if (n < NCHUNK) { o0[(size_t)n * 16384] = (bf16)f2bf(S0); S0 = e0[j] * S0 + u0[j]; if (two) o1[(size_t)n * 16384] = (bf16)f2bf(S1); S1 = e1[j] * S1 + u1[j]; } }
        }
    }
}
__device__ __forceinline__ void hgrn_h3(const Frame& F, const float* QA, const float* GL, const float* GT, const bf16* VA, const bf16* SS, const float* gnw, bf16* MIX) {
    LAS bf16* QS = (LAS bf16*)(F.lds + 0);
    LAS bf16* KS = (LAS bf16*)(F.lds + 17408);
    LAS bf16* VT = (LAS bf16*)(F.lds + 60928);
    LAS bf16* P  = (LAS bf16*)(F.lds + 79360);
    LAS float* TOT = (LAS float*)(F.lds + 88576);
    LAS float* OB = (LAS float*)(F.lds + 90624);
    const int tid = F.tid, lane = F.lane, w = F.wave, k = tid & 127, sc = tid >> 7;
    for (int unit = F.vcu; unit < A_HEADS * NCHUNK; unit += F.G) {
        const int hh = unit / NCHUNK, n = unit % NCHUNK;
        float g[16], q[16], cs[16]; float run = 0.f;
#pragma unroll
        for (int i = 0; i < 16; ++i) { const int r = hg_row(n, 16 * sc + i); const size_t o = (size_t)(r >= 0 ? r : 0) * 2048 + hh * 128 + k; g[i] = r >= 0 ? GL[o] : 0.f; q[i] = r >= 0 ? QA[o] : 0.f; }
#pragma unroll
        for (int i = 0; i < 16; ++i) { run += g[i]; cs[i] = run; }
        TOT[sc * 128 + k] = run;
        hg_load_vt(VA, hh, n, VT, tid);
        for (int i = tid; i < 64 * 72 / 2; i += 512) ((LAS unsigned*)P)[i] = 0u;
        __syncthreads();
        float R[4]; { float a = 0.f;
#pragma unroll
            for (int j = 0; j < 4; ++j) { R[j] = a; a += TOT[j * 128 + k]; } }
        float off = 0.f;
#pragma unroll
        for (int j = 0; j < 4; ++j) off = (j == sc) ? R[j] : off;
#pragma unroll
        for (int i = 0; i < 16; ++i) QS[(16 * sc + i) * 136 + k] = (bf16)f2bf(q[i] * fexp(cs[i]));
#pragma unroll
        for (int i2 = 0; i2 < 4; ++i2) if (i2 >= sc) { const int base = (i2 * (i2 + 1) / 2) * 16; const float rr = R[i2] - off;
#pragma unroll
            for (int i = 0; i < 16; ++i) KS[(base + 16 * sc + i) * 136 + k] = (bf16)f2bf((1.0f - fexp(g[i])) * fexp(rr - cs[i])); }
        __syncthreads();
        for (int b = w; b < 10; b += 8) { const int i = b >= 6 ? 3 : (b >= 3 ? 2 : (b >= 1 ? 1 : 0)), j = b - i * (i + 1) / 2, base = (i * (i + 1) / 2) * 16;
            f32x4 acc = (f32x4){0.f, 0.f, 0.f, 0.f}; acc = mma_nt(QS + 16 * i * 136, 136, KS + (base + 16 * j) * 136, 136, 4, acc, lane);
#pragma unroll
            for (int rg = 0; rg < 4; ++rg) { const int tr = 4 * (lane >> 4) + rg, sccol = lane & 15; const float v = (j < i || sccol <= tr) ? acc[rg] : 0.f; P[(16 * i + tr) * 72 + 16 * j + sccol] = (bf16)f2bf(v); } }
        __syncthreads();
#pragma unroll
        for (int i = 0; i < 16; ++i) QS[(16 * sc + i) * 136 + k] = (bf16)f2bf(q[i] * fexp(cs[i] + off));
        { LAS bf16* ST = KS; const int kk = tid >> 2, vq = tid & 3; const GAS v4u* sp = (const GAS v4u*)(SS + (size_t)unit * 16384 + (size_t)kk * 128 + vq * 32);
#pragma unroll
            for (int j = 0; j < 4; ++j) { const v4u s = sp[j]; const unsigned wv[4] = {s.x, s.y, s.z, s.w};
#pragma unroll
                for (int e = 0; e < 4; ++e) { ST[(vq * 32 + 8 * j + 2 * e) * 136 + kk] = (bf16)(wv[e] & 0xffffu); ST[(vq * 32 + 8 * j + 2 * e + 1) * 136 + kk] = (bf16)(wv[e] >> 16); } } }
        __syncthreads();
        { const LAS bf16* ST = KS; const int tb = w >> 1, vb0 = 4 * (w & 1);
#pragma unroll
            for (int vb = 0; vb < 4; ++vb) { f32x4 acc = (f32x4){0.f, 0.f, 0.f, 0.f};
                acc = mma_nt(QS + 16 * tb * 136, 136, ST + 16 * (vb0 + vb) * 136, 136, 4, acc, lane);
                acc = mma_nt(P + 16 * tb * 72, 72, VT + 16 * (vb0 + vb) * 72, 72, 2, acc, lane);
#pragma unroll
                for (int rg = 0; rg < 4; ++rg) OB[(16 * tb + 4 * (lane >> 4) + rg) * 128 + 16 * (vb0 + vb) + (lane & 15)] = acc[rg]; } }
        __syncthreads();
        for (int i = 0; i < 8; ++i) { const int t = 8 * w + i, r = hg_row(n, t); if (r < 0) continue;
            const f32x2 o = *(const LAS f32x2*)(OB + t * 128 + 2 * lane); const float ss = wave_sum(o.x * o.x + o.y * o.y); const float rstd = 1.0f / sqrtf(ss * (1.f / 128.f) + NORM_EPS);
            const f32x2 gt = *(const GAS f32x2*)(GT + (size_t)r * 2048 + hh * 128 + 2 * lane), gw2 = *(const GAS f32x2*)(gnw + 2 * lane);
            *(GAS unsigned*)(MIX + (size_t)r * DM + hh * 128 + 2 * lane) = pk2(o.x * rstd * gw2.x * gt.x, o.y * rstd * gw2.y * gt.y); }
        __syncthreads();
    }
}
__device__ __forceinline__ void attn_phase(const Frame& F, const bf16* QB, const bf16* KB, const bf16* VB, const float* sinks, bf16* MIX) {
    LAS bf16* KL = (LAS bf16*)(F.lds + 0);
    LAS bf16* VT = (LAS bf16*)(F.lds + 41472);
    const int tid = F.tid, lane = F.lane, w = F.wave, g = lane >> 4, ql = lane & 15;
    for (int unit = F.vcu; unit < 260; unit += F.G) {
        const bool meta = unit >= 256; const int kvh = meta ? unit - 256 : unit >> 6, jb = meta ? 0 : unit & 63;
        for (int pass = 0; pass < 5; ++pass) { const int key = pass * 64 + (tid >> 3), d8 = (tid & 7) * 8; if (key >= 288) break;
            int r = -1;
            if (key < 128) r = (!meta && jb >= 1) ? 128 * (jb - 1) + key : -1; else if (key < 256) r = !meta ? 128 * jb + key - 128 : -1; else if (key < 272) r = SEQ + key - 256;
            v4u kk = (v4u){0u, 0u, 0u, 0u}, vv = kk;
            if (r >= 0) { kk = *(const GAS v4u*)(KB + (size_t)r * 256 + kvh * 64 + d8); vv = *(const GAS v4u*)(VB + (size_t)r * 256 + kvh * 64 + d8); }
            *(LAS v4u*)(KL + key * 72 + d8) = kk;
            const unsigned wv[4] = {vv.x, vv.y, vv.z, vv.w};
#pragma unroll
            for (int j = 0; j < 4; ++j) { VT[(d8 + 2 * j) * 296 + key] = (bf16)(wv[j] & 0xffffu); VT[(d8 + 2 * j + 1) * 296 + key] = (bf16)(wv[j] >> 16); } }
        __syncthreads();
        if (!meta || w == 0) {
            const int qi = meta ? ql : 16 * w + ql; const int qrow = meta ? SEQ + ql : 128 * jb + qi;
            for (int g8 = 0; g8 < 8; ++g8) { const int head = kvh * 8 + g8;
                const GAS bf16x8* qp = (const GAS bf16x8*)(QB + (size_t)qrow * 2048 + head * 64 + 8 * g);
                const bf16x8 q0 = qp[0], q1 = qp[4];
                f32x4 s[18]; const float sk = sinks[head]; float mx = sk;
#pragma unroll
                for (int kb = 0; kb < 18; ++kb) { f32x4 acc = (f32x4){0.f, 0.f, 0.f, 0.f}; const LAS bf16* kp = KL + (16 * kb + ql) * 72 + 8 * g;
                    acc = __builtin_amdgcn_mfma_f32_16x16x32_bf16(*(const LAS bf16x8*)kp, q0, acc, 0, 0, 0); acc = __builtin_amdgcn_mfma_f32_16x16x32_bf16(*(const LAS bf16x8*)(kp + 32), q1, acc, 0, 0, 0);
#pragma unroll
                    for (int rg = 0; rg < 4; ++rg) { const int kk = 16 * kb + 4 * g + rg; bool ok;
                        if (meta) ok = kk >= 256 && kk < 272 && (kk - 256) <= qi; else ok = kk < 128 ? (jb >= 1 && kk >= qi + 1) : (kk < 256 ? (kk - 128 <= qi) : kk < 272);
                        acc[rg] = ok ? acc[rg] * 0.125f : -1e30f; mx = fmaxf(mx, acc[rg]); }
                    s[kb] = acc; if (kb & 1) __builtin_amdgcn_sched_barrier(0); }
                mx = fmaxf(mx, __shfl_xor(mx, 16)); mx = fmaxf(mx, __shfl_xor(mx, 32));
                float l = 0.f; bf16x8 pf[9];
#pragma unroll
                for (int pp = 0; pp < 9; ++pp) { float e[8];
#pragma unroll
                    for (int rg = 0; rg < 4; ++rg) { e[rg] = fexp(s[2 * pp][rg] - mx); e[4 + rg] = fexp(s[2 * pp + 1][rg] - mx); }
#pragma unroll
                    for (int j = 0; j < 8; ++j) l += e[j];
                    const v4u pw = (v4u){pk2(e[0], e[1]), pk2(e[2], e[3]), pk2(e[4], e[5]), pk2(e[6], e[7])}; pf[pp] = __builtin_bit_cast(bf16x8, pw); }
                l += __shfl_xor(l, 16); l += __shfl_xor(l, 32); l += fexp(sk - mx);
                const float inv = 1.0f / l;
#pragma unroll 1
                for (int db = 0; db < 4; ++db) { f32x4 acc = (f32x4){0.f, 0.f, 0.f, 0.f}; const LAS bf16* vp = VT + (16 * db + ql) * 296 + 4 * g;
#pragma unroll
                    for (int pp = 0; pp < 9; ++pp) { const v2u lo = *(const LAS v2u*)(vp + 32 * pp), hi = *(const LAS v2u*)(vp + 32 * pp + 16); const v4u av = (v4u){lo.x, lo.y, hi.x, hi.y};
                        acc = __builtin_amdgcn_mfma_f32_16x16x32_bf16(__builtin_bit_cast(bf16x8, av), pf[pp], acc, 0, 0, 0); }
                    v2u o; o.x = pk2(acc[0] * inv, acc[1] * inv); o.y = pk2(acc[2] * inv, acc[3] * inv);
                    *(GAS v2u*)(MIX + (size_t)qrow * DM + 2048 + head * 64 + 16 * db + 4 * g) = o; }
            }
        }
        __syncthreads();
    }
}
constexpr int SK_MAXI = 6;
template <int NB, class Epi>
__device__ __forceinline__ void skinny_gemm(const Frame& F, const bf16* A, int lda, const bf16* Bt, int ldb, int K, int nitems, int ipb, int pstride, int ashift, const Epi& epi) {
    LAS float* RED = (LAS float*)(F.lds + 0);
    LAS float* FIN = (LAS float*)(F.lds + 49152);
    const int lane = F.lane, w = F.wave, g = lane >> 4, ql = lane & 15, kw = K >> 3, nks = kw >> 5;
    for (int b0 = F.vcu; b0 < nitems; b0 += F.G * (SK_MAXI / NB)) {
    int nmine = 0;
    for (int item = b0; item < nitems && nmine < SK_MAXI / NB; item += F.G, ++nmine) {
        const int brow = (item / ipb) * pstride + (item % ipb) * 16;
        const int acol = ashift >= 0 ? (((item / ipb) >> ashift) << 8) : 0;
        const GAS bf16x8* ap = (const GAS bf16x8*)(A + (size_t)ql * lda + acol + w * kw + 8 * g);
        const GAS bf16x8* bp0 = (const GAS bf16x8*)(Bt + (size_t)(brow + ql) * ldb + w * kw + 8 * g);
        const GAS bf16x8* bp1 = (const GAS bf16x8*)(Bt + (size_t)(brow + 128 + ql) * ldb + w * kw + 8 * g);
        f32x4 acc0 = (f32x4){0.f, 0.f, 0.f, 0.f}, acc1 = acc0;
#pragma unroll 8
        for (int s = 0; s < nks; ++s) { const bf16x8 a = ap[4 * s], b0 = bp0[4 * s];
            acc0 = __builtin_amdgcn_mfma_f32_16x16x32_bf16(b0, a, acc0, 0, 0, 0);
            if (NB == 2) { const bf16x8 b1 = bp1[4 * s]; acc1 = __builtin_amdgcn_mfma_f32_16x16x32_bf16(b1, a, acc1, 0, 0, 0); } }
        LAS float* red = RED + (size_t)(nmine * 8 + w) * NB * 256;
#pragma unroll
        for (int rg = 0; rg < 4; ++rg) { red[(4 * g + rg) * 16 + ql] = acc0[rg]; if (NB == 2) red[256 + (4 * g + rg) * 16 + ql] = acc1[rg]; }
    }
    __syncthreads();
    for (int e = F.tid; e < nmine * NB * 256; e += 512) { const int i = e / (NB * 256), r = e % (NB * 256); float s = 0.f;
#pragma unroll
        for (int ww = 0; ww < 8; ++ww) s += RED[(size_t)(i * 8 + ww) * NB * 256 + r];
        FIN[e] = s; }
    __syncthreads();
    if (F.tid < 256) for (int i = 0; i < nmine; ++i) epi(b0 + i * F.G, F.tid >> 4, F.tid & 15, FIN + i * NB * 256);
    __syncthreads();
    }
}
#ifndef MK_SINGLE
#define MK_SINGLE 1
#endif
constexpr int N_PHASES = 22;
#ifndef PHMASK
#define PHMASK 0xffffffu
#endif
#define EN(k) (((PHMASK) >> ((k) % 24)) & 1u)
#define IN(k) (EN(k) && lo <= (k) && (k) < hi)
#define SEAM(k) do { if (IN(k) && IN((k) + 1)) xcd_barrier(bar); } while (0)
template <int L> __device__ __forceinline__ void layer_tail(Frame& F, const XcdBarrier& bar, int lo, int hi, const bf16* mixA) {
    constexpr int pb = (L == 0) ? 5 : 16;
    unsigned char* ws = F.ws; bf16* XN = (bf16*)(ws + WS_XN); float* H = (float*)(ws + WS_H); float* Y = (float*)(ws + WS_Y); unsigned char* ar = ws + WS_AR; const float* nw = F.in[2];
        if (IN(pb)) {
            pg8::Gemm g{mixA, (const bf16*)(ws + (L == 0 ? WS_WOUT_E : WS_WOUT_O)), SEQ, DM, DM, DM, DM, -1}; pg8::StaticOrder S; S.init(SEQ, DM, F.G, (int)blockIdx.x);
            pg8::EpiF32 E{Y, DM};
            pg8::gemm_phase<pg8::EpiF32, pg8::StaticOrder, true, true>(F.lds + RING_OFF, g, S, E);
            skinny_gemm<1>(F, g.A + (size_t)SEQ * g.lda, g.lda, g.Bt, g.ldb, g.K, DM / 16, 1, 16, -1, [=](int item, int n, int m, const LAS float* fin) { Y[(size_t)(SEQ + m) * DM + item * 16 + n] = fin[n * 16 + m]; });
        } SEAM(pb);
        if (IN(pb + 1)) { norm_pass(F, Y, L == 0, H, nw + (size_t)(L * 4 + 1) * DM, nw + (size_t)(L * 4 + 2) * DM, H, XN, 0); } SEAM(pb + 1);
        if (IN(pb + 2)) {
            pg8::Gemm g{XN, (const bf16*)(ws + WS_WGU + (size_t)L * SZ_WGU), SEQ, 2 * DFF, DM, DM, DM, -1}; pg8::StaticOrder S; S.init(SEQ, 2 * DFF, F.G, (int)blockIdx.x);
            const float* cw = F.in[18] + (size_t)L * 3 * DFF; const float* cb = F.in[19] + (size_t)L * DFF; bf16* ACT = (bf16*)(ar + AR_ACT); float* HG = (float*)(ar + AR_HG);
            pg8::EpiGUAct E{ACT, HG, (float*)(ar + AR_HU), cw, cb};
            pg8::gemm_phase<pg8::EpiGUAct, pg8::StaticOrder, true, true>(F.lds + RING_OFF, g, S, E);
            skinny_gemm<2>(F, XN + (size_t)SEQ * DM, DM, g.Bt, DM, DM, (DFF / 128) * 8, 8, 256, -1, [=](int item, int n, int m, const LAS float* fin) {
                const int ch = (item >> 3) * 128 + (item & 7) * 16 + n; const float gg = fin[n * 16 + m], up = fin[256 + n * 16 + m];
                const float gm1 = m >= 1 ? fin[n * 16 + m - 1] : 0.f, gm2 = m >= 2 ? fin[n * 16 + m - 2] : 0.f;
                const float v = cb[ch] + cw[ch] * gm2 + cw[DFF + ch] * gm1 + cw[2 * DFF + ch] * gg;
                ACT[(size_t)(SEQ + m) * DFF + ch] = (bf16)f2bf(fgelu_tanh(v) * up);
                if (m >= 14) HG[(size_t)(128 * 4 + 2 + m - 14) * DFF + ch] = gg; });
        } SEAM(pb + 2);
        if (IN(pb + 3)) { ffn_fixup(F, (const float*)(ar + AR_HG), (const float*)(ar + AR_HU), F.in[18] + (size_t)L * 3 * DFF, F.in[19] + (size_t)L * DFF, (bf16*)(ar + AR_ACT)); } SEAM(pb + 3);
        if (IN(pb + 4)) {
            pg8::Gemm g{(const bf16*)(ar + AR_ACT), (const bf16*)(ws + WS_WD + (size_t)L * SZ_WD), SEQ, DM, DFF, DFF, DFF, -1}; pg8::StaticOrder S; S.init(SEQ, DM, F.G, (int)blockIdx.x);
            pg8::EpiF32 E{Y, DM};
            pg8::gemm_phase<pg8::EpiF32, pg8::StaticOrder, true, true>(F.lds + RING_OFF, g, S, E);
            skinny_gemm<1>(F, g.A + (size_t)SEQ * g.lda, g.lda, g.Bt, g.ldb, g.K, DM / 16, 1, 16, -1, [=](int item, int n, int m, const LAS float* fin) { Y[(size_t)(SEQ + m) * DM + item * 16 + n] = fin[n * 16 + m]; });
        } SEAM(pb + 4);
        if (IN(pb + 5)) {
            if (L == 0) norm_pass(F, Y, 0, H, nw + (size_t)3 * DM, nw + (size_t)4 * DM, H, XN, 0);
            else norm_pass(F, Y, 0, H, nw + (size_t)7 * DM, nullptr, F.out, nullptr, 1);
        }
        if (L == 0) SEAM(pb + 5);
}
struct Args { const float* in[21]; float* out; unsigned char* ws; int ph_lo, ph_hi; };
__global__ void __launch_bounds__(NWAVES * 64, 2) fwd_kernel(Args args) {
    extern __shared__ __attribute__((aligned(16))) unsigned char lds[];
    Frame F;
    F.lds = (LAS unsigned char*)lds;
    F.MISC = (volatile LAS unsigned*)(F.lds + MISC_OFF);
    F.tid = threadIdx.x; F.lane = F.tid & 63; F.wave = __builtin_amdgcn_readfirstlane(F.tid >> 6);
    F.G = gridDim.x; { const int bx = blockIdx.x; F.vcu = (F.G % 8 == 0) ? (bx % 8) * (F.G / 8) + bx / 8 : bx; }
    unsigned char* ws = args.ws; F.ws = ws;
    F.ctl = (gu32*)(ws + WS_CTL);
#pragma unroll
    for (int i = 0; i < 21; ++i) F.in[i] = args.in[i];
    F.out = args.out;
    for (int u = F.tid; u < (LDS_BYTES - LDSCTL_OFF) / 4; u += NWAVES * 64) ((LAS unsigned*)(F.lds + LDSCTL_OFF))[u] = 0u;
    __syncthreads();
    const int lo = args.ph_lo, hi = args.ph_hi;
    XcdBarrier bar; bar.bar = (unsigned*)(F.ctl + CW_BAR); bar.x = 0; bar.st = nullptr;
    if (hi - lo > 1) bar = xcd_barrier_post((unsigned*)(F.ctl + CW_BAR), F.MISC + 8);
    bf16* XN = (bf16*)(ws + WS_XN); float* H = (float*)(ws + WS_H); float* Y = (float*)(ws + WS_Y); unsigned char* ar = ws + WS_AR;
    const float* nw = F.in[2];

    if (IN(0)) { p0_prologue(F); } SEAM(0);

    {
        const bf16* mixA;
        {
            mixA = (const bf16*)(ar + AR_MIX);
            if (IN(1)) {
                pg8::Gemm g{XN, (const bf16*)(ws + WS_WIN_E), SEQ, EVEN_IN, DM, DM, DM, -1}; pg8::StaticOrder S; S.init(SEQ, EVEN_IN, F.G, (int)blockIdx.x);
                pg8::EpiInEven E{(float*)(ar + AR_QA), (float*)(ar + AR_GL), (float*)(ar + AR_GT), (bf16*)(ar + AR_VA), (bf16*)(ar + AR_QB), (bf16*)(ar + AR_KB), (bf16*)(ar + AR_VB), F.in[4]};
                pg8::gemm_phase<pg8::EpiInEven, pg8::StaticOrder, true, true>(F.lds + RING_OFF, g, S, E);
                { float* QA = (float*)(ar + AR_QA); float* GL = (float*)(ar + AR_GL); float* GT = (float*)(ar + AR_GT); bf16* VA = (bf16*)(ar + AR_VA); bf16* QB = (bf16*)(ar + AR_QB); bf16* KB = (bf16*)(ar + AR_KB); bf16* VB = (bf16*)(ar + AR_VB); const float* lbl = F.in[4];
                  skinny_gemm<1>(F, XN + (size_t)SEQ * DM, DM, (const bf16*)(ws + WS_WIN_E), DM, DM, EVEN_IN / 16, 1, 16, -1, [=](int item, int n, int m, const LAS float* fin) {
                    const float v = fin[n * 16 + m]; const int col = item * 16 + n; const size_t r = (size_t)(SEQ + m); const int seg = col >> 11, c = col & 2047;
                    if (seg == 0) QA[r * 2048 + c] = fsilu(v);
                    else if (seg == 1) { const float lb = frcp(1.0f + fexp(lbl[2048 + c] - lbl[c])); GL[r * 2048 + c] = __logf(lb + (1.0f - lb) * fsigmoid(v)); }
                    else if (seg == 2) VA[r * 2048 + c] = (bf16)f2bf(v);
                    else if (seg == 3) GT[r * 2048 + c] = fsilu(v);
                    else if (seg == 4) QB[r * 2048 + c] = (bf16)f2bf(v);
                    else if (c < 256) KB[r * 256 + c] = (bf16)f2bf(v);
                    else VB[r * 256 + c - 256] = (bf16)f2bf(v); }); }
            } SEAM(1);
            if (IN(2)) {
                attn_phase(F, (const bf16*)(ar + AR_QB), (const bf16*)(ar + AR_KB), (const bf16*)(ar + AR_VB), F.in[6], (bf16*)(ar + AR_MIX));
                hgrn_h1(F, (const float*)(ar + AR_GL), (const bf16*)(ar + AR_VA), (float*)(ar + AR_US), (float*)(ar + AR_DS));
            } SEAM(2);
            if (IN(3)) { hgrn_h2(F, (const float*)(ar + AR_US), (const float*)(ar + AR_DS), (bf16*)(ar + AR_SS)); } SEAM(3);
            if (IN(4)) { hgrn_h3(F, (const float*)(ar + AR_QA), (const float*)(ar + AR_GL), (const float*)(ar + AR_GT), (const bf16*)(ar + AR_VA), (const bf16*)(ar + AR_SS), F.in[5], (bf16*)(ar + AR_MIX)); } SEAM(4);
        }
        layer_tail<0>(F, bar, lo, hi, mixA);
        {
            mixA = (const bf16*)(ar + AR_LO);
            if (IN(11)) {
                pg8::Gemm g{XN, (const bf16*)(ws + WS_WIN_O), SEQ, 8192, DM, DM, DM, -1}; pg8::StaticOrder S; S.init(SEQ, 8192, F.G, (int)blockIdx.x);
                pg8::EpiInOdd E{(bf16*)(ar + AR_YBR), (float*)(ar + AR_XBR)};
                pg8::gemm_phase<pg8::EpiInOdd, pg8::StaticOrder, true, true>(F.lds + RING_OFF, g, S, E);
                { bf16* YB = (bf16*)(ar + AR_YBR); float* XB = (float*)(ar + AR_XBR);
                  skinny_gemm<1>(F, XN + (size_t)SEQ * DM, DM, (const bf16*)(ws + WS_WIN_O), DM, DM, 8192 / 16, 1, 16, -1, [=](int item, int n, int m, const LAS float* fin) {
                    const float v = fin[n * 16 + m]; const int col = item * 16 + n; const size_t r = (size_t)(SEQ + m);
                    if (col < DM) YB[r * DM + col] = (bf16)f2bf(fgelu_tanh(v)); else XB[r * DM + col - DM] = v; }); }
            } SEAM(11);
            if (IN(12)) { lru_conv_pass(F, (const float*)(ar + AR_XBR), F.in[9], F.in[10], (float*)(ar + AR_XC), (bf16*)(ar + AR_XCB)); } SEAM(12);
            if (IN(13)) {
                pg8::Gemm g{(const bf16*)(ar + AR_XCB), (const bf16*)(ws + WS_WG), SEQ, 8192, 256, DM, 256, 1}; pg8::StaticOrder S; S.init(SEQ, 8192, F.G, (int)blockIdx.x);
                pg8::EpiGates E{(const float*)(ar + AR_XC), F.in[12], F.in[14], (const float*)(ws + WS_LS8), (unsigned*)(ar + AR_AB)};
                pg8::gemm_phase<pg8::EpiGates, pg8::StaticOrder, true, true>(F.lds + RING_OFF, g, S, E);
                { const float* XC = (const float*)(ar + AR_XC); const float* ba = F.in[12]; const float* bx = F.in[14]; const float* ls8 = (const float*)(ws + WS_LS8); unsigned* ABo = (unsigned*)(ar + AR_AB);
                  skinny_gemm<2>(F, (const bf16*)(ar + AR_XCB) + (size_t)SEQ * DM, DM, (const bf16*)(ws + WS_WG), 256, 256, 32 * 8, 8, 256, 1, [=](int item, int n, int m, const LAS float* fin) {
                    const int p = item >> 3, j = item & 7, ch = (p >> 1) * 256 + (p & 1) * 128 + 16 * j + n; const size_t o = (size_t)(SEQ + m) * DM + ch;
                    const float ga = fin[n * 16 + m], gx = fin[256 + n * 16 + m];
                    const float la = ls8[ch] * fsigmoid(ga + ba[ch]); const float t = 2.0f * la;
                    const float ser = t * (1.0f + 0.5f * t * (1.0f + (1.0f / 3.0f) * t * (1.0f + 0.25f * t * (1.0f + 0.2f * t * (1.0f + (1.0f / 6.0f) * t)))));
                    const float em1 = t > -0.25f ? ser : fexp(t) - 1.0f;
                    ABo[o] = pk2(la, __builtin_sqrtf(-em1) * (fsigmoid(gx + bx[ch]) * XC[o])); }); }
            } SEAM(13);
            if (IN(14)) { lru_scan1(F, (const unsigned*)(ar + AR_AB), (float*)(ar + AR_CA), (float*)(ar + AR_CB)); } SEAM(14);
            if (IN(15)) { lru_scan2(F, (const unsigned*)(ar + AR_AB), (const float*)(ar + AR_CA), (const float*)(ar + AR_CB), (const bf16*)(ar + AR_YBR), (bf16*)(ar + AR_LO)); } SEAM(15);
        }
        layer_tail<1>(F, bar, lo, hi, mixA);
    }
}

#ifndef DBG_STOP
#define DBG_STOP -1
#endif
__global__ void dbg_copy_h(const float4* __restrict__ h, float4* __restrict__ o, size_t n4) { for (size_t i = (size_t)blockIdx.x * blockDim.x + threadIdx.x; i < n4; i += (size_t)gridDim.x * blockDim.x) o[i] = h[i]; }
extern "C" void kernel_launch(void* const* d_in, const int* in_sizes, int n_in, void* d_out, int out_size, void* d_ws, size_t ws_size, hipStream_t stream) {
    static int grid = 0;
    if (grid == 0) {
        if (n_in != 21 || out_size != SEQ * DM || ws_size < WS_END) { fprintf(stderr, "kernel_launch: unexpected problem (n_in %d out %d ws %zu need %zu)\n", n_in, out_size, ws_size, (size_t)WS_END); grid = -1; return; }
        int dev = 0, cus = 0, per_cu = 0;
        if (hipGetDevice(&dev) != hipSuccess || hipDeviceGetAttribute(&cus, hipDeviceAttributeMultiprocessorCount, dev) != hipSuccess) { grid = -1; return; }
        if (hipFuncSetAttribute((const void*)fwd_kernel, hipFuncAttributeMaxDynamicSharedMemorySize, LDS_BYTES) != hipSuccess) { fprintf(stderr, "kernel_launch: hipFuncSetAttribute failed\n"); grid = -1; return; }
        if (hipOccupancyMaxActiveBlocksPerMultiprocessor(&per_cu, (const void*)fwd_kernel, NWAVES * 64, LDS_BYTES) != hipSuccess || per_cu < 1) fprintf(stderr, "kernel_launch: occupancy query says %d\n", per_cu);
        (void)hipGetLastError();
        grid = cus;
    }
    if (grid < 0) return;
    (void)hipMemsetAsync((char*)d_ws + WS_CTL, 0, CTL_ZERO_BYTES, stream);
    Args a{};
    for (int i = 0; i < 21; ++i) a.in[i] = (const float*)d_in[i];
    a.out = (float*)d_out; a.ws = (unsigned char*)d_ws;
#if MK_SINGLE
    a.ph_lo = 0; a.ph_hi = N_PHASES;
    hipLaunchKernelGGL(fwd_kernel, dim3(grid), dim3(NWAVES * 64), LDS_BYTES, stream, a);
#else
    const int last = (DBG_STOP >= 0) ? DBG_STOP : N_PHASES - 1;
#ifndef REPMASK
#define REPMASK 0u
#endif
    for (int k = 0; k <= last; ++k) { a.ph_lo = k; a.ph_hi = k + 1; const int nrep = ((REPMASK >> k) & 1u) ? 2 : 1;
        for (int rep = 0; rep < nrep; ++rep) hipLaunchKernelGGL(fwd_kernel, dim3(grid), dim3(NWAVES * 64), LDS_BYTES, stream, a); }
    if (DBG_STOP >= 0) hipLaunchKernelGGL(dbg_copy_h, dim3(2048), dim3(256), 0, stream, (const float4*)((const char*)d_ws + WS_H), (float4*)d_out, (size_t)SEQ * DM / 4);
#endif
}
```
